# Optimizing an MI355X kernel written in HIP

```python
import math, functools
import jax, jax.numpy as jnp
from jax import lax
import numpy as np

D_MODEL = 1024
BATCH = 32
SEQ = 256
DEPTH = 4
DEC_BATCH = 4
DEC_SEQ = 2048
PAST_LEN = 256

GRID_W = 64
N_MIXERS = 3
N_SSD_LAYERS = (DEPTH + 2) // 3
N_CONV_LAYERS = (DEPTH + 1) // 3
N_DIFF_LAYERS = DEPTH // 3
SSM_D_INNER = 2 * D_MODEL
SSM_HEAD_DIM = 64
SSM_HEADS = SSM_D_INNER // SSM_HEAD_DIM
SSM_GROUPS = 8
SSM_STATE = 128
SSM_CONV = 3
SSM_CHUNK = 128
SSM_CONV_DIM = SSM_D_INNER + 2 * SSM_GROUPS * SSM_STATE
SSM_IN_DIM = SSM_D_INNER + SSM_CONV_DIM + 2 * SSM_HEADS
SHORT_CONV = 3
DIFF_HEAD_DIM = 64
DIFF_HEADS = D_MODEL // (2 * DIFF_HEAD_DIM)
Q_BLOCK = 128
ROPE_THETA = 10000.0
ROT_PAIRS_PER_AXIS = DIFF_HEAD_DIM // 4
FFN_DIM = 2816
FFN_CONV = 3
NORM_EPS = 1e-6

kernel_name = 'hybrid_diffusion_ssd_conv_diffattn_step'


def rmsnorm(x, g):
    xf = x.astype(jnp.float32)
    y = xf * lax.rsqrt(jnp.mean(xf * xf, axis=-1, keepdims=True) + NORM_EPS)
    return (y * g.astype(jnp.float32)).astype(x.dtype)


def modulation(cond, w, b):
    return jax.nn.silu(cond) @ w + b


def sandwich_layer(x, mod, g, mix_fn, ffn_fn):
    sh1, sc1, gt1, sh2, sc2, gt2 = jnp.split(mod, 6, axis=-1)
    m, aux = mix_fn(rmsnorm(x, g[0]) * (1 + sc1) + sh1)
    x = x + gt1 * rmsnorm(m, g[1])
    f = ffn_fn(rmsnorm(x, g[2]) * (1 + sc2) + sh2)
    x = x + gt2 * rmsnorm(f, g[3])
    return x, aux


def dwconv(x, w):
    k = w.shape[0]
    pad = k // 2
    L = x.shape[1]
    xp = jnp.pad(x, ((0, 0), (pad, pad), (0, 0)))
    out = xp[:, 0:L] * w[0]
    for i in range(1, k):
        out = out + xp[:, i:i + L] * w[i]
    return out


def conv_ffn(h, w_up, conv_w, w_down):
    u = dwconv(h @ w_up, conv_w)
    gate, val = jnp.split(u, 2, axis=-1)
    return (jax.nn.silu(gate) * val) @ w_down


def short_conv_mixer(h, w_in, conv_w, w_out):
    bg, cg, u = jnp.split(h @ w_in, 3, axis=-1)
    return (bg * dwconv(cg * u, conv_w)) @ w_out, None


def ssd_scan(x, dt, a, b_in, c_in, h0):
    bsz, L, H, P = x.shape
    G, N = b_in.shape[2], b_in.shape[3]
    R = H // G
    nc = L // SSM_CHUNK
    f32 = jnp.float32
    xf = x.astype(f32).reshape(bsz, nc, SSM_CHUNK, G, R, P)
    dtc = dt.reshape(bsz, nc, SSM_CHUNK, G, R)
    bc = b_in.astype(f32).reshape(bsz, nc, SSM_CHUNK, G, N)
    cc = c_in.astype(f32).reshape(bsz, nc, SSM_CHUNK, G, N)
    acs = jnp.cumsum(dtc * a.reshape(G, R), axis=2)
    mask = jnp.tril(jnp.ones((SSM_CHUNK, SSM_CHUNK), bool))[:, :, None, None]
    decay = jnp.exp(jnp.where(mask, acs[:, :, :, None] - acs[:, :, None], -jnp.inf))
    cb = jnp.einsum('bcqgn,bcsgn->bcqsg', cc, bc)
    y_diag = jnp.einsum('bcqsgr,bcsgrp->bcqgrp', cb[..., None] * decay * dtc[:, :, None], xf)
    xw = xf * (jnp.exp(acs[:, :, -1:] - acs) * dtc)[..., None]
    chunk_states = jnp.einsum('bcsgn,bcsgrp->bcgrpn', bc, xw)
    chunk_decay = jnp.exp(acs[:, :, -1])

    def step(h, inp):
        st, dec = inp
        return h * dec[..., None, None] + st, h

    h_last, h_in = lax.scan(step, h0.astype(f32).reshape(bsz, G, R, P, N),
                            (jnp.swapaxes(chunk_states, 0, 1), jnp.swapaxes(chunk_decay, 0, 1)))
    h_in = jnp.swapaxes(h_in, 0, 1)
    y_off = jnp.einsum('bcqgn,bcgrpn->bcqgrp', cc, h_in) * jnp.exp(acs)[..., None]
    return (y_diag + y_off).reshape(bsz, L, H, P), h_last.reshape(bsz, H, P, N)


def ssd_mixer(h, h0, w_in, conv_w, conv_b, dt_bias, a_log, d_skip, norm_g, w_out):
    bsz, L, _ = h.shape
    z, xbc, dt_raw = jnp.split(h @ w_in, [SSM_D_INNER, SSM_D_INNER + SSM_CONV_DIM], axis=-1)
    xbc = jax.nn.silu(dwconv(xbc, conv_w) + conv_b)
    xs, bm, cm = jnp.split(xbc, [SSM_D_INNER, SSM_D_INNER + SSM_GROUPS * SSM_STATE], axis=-1)
    xs = xs.reshape(bsz, L, SSM_HEADS, SSM_HEAD_DIM)
    bm = bm.reshape(bsz, L, SSM_GROUPS, SSM_STATE)
    cm = cm.reshape(bsz, L, SSM_GROUPS, SSM_STATE)
    dt = jax.nn.softplus(dt_raw.astype(jnp.float32) + dt_bias.reshape(-1).astype(jnp.float32))
    dt_f, dt_b = jnp.split(dt, 2, axis=-1)
    a = -jnp.exp(a_log.astype(jnp.float32))
    y_f, s_f = ssd_scan(xs, dt_f, a[0], bm, cm, h0[:, 0])
    flip = lambda t: jnp.flip(t, axis=1)
    y_b, s_b = ssd_scan(flip(xs), flip(dt_b), a[1], flip(bm), flip(cm), h0[:, 1])
    y = y_f + flip(y_b) + d_skip.astype(jnp.float32)[:, None] * xs.astype(jnp.float32)
    y = rmsnorm(y.reshape(bsz, L, SSM_D_INNER) * jax.nn.silu(z.astype(jnp.float32)), norm_g)
    return y.astype(h.dtype) @ w_out, jnp.stack([s_f, s_b], axis=1)


def axial_rotary(n_tokens):
    rows = n_tokens // GRID_W
    row = jnp.repeat(jnp.arange(rows, dtype=jnp.float32), GRID_W)
    col = jnp.tile(jnp.arange(GRID_W, dtype=jnp.float32), rows)
    inv = ROPE_THETA ** (-jnp.arange(ROT_PAIRS_PER_AXIS, dtype=jnp.float32) / ROT_PAIRS_PER_AXIS)
    ang = jnp.concatenate([row[:, None] * inv, col[:, None] * inv], axis=-1)
    return jnp.cos(ang), jnp.sin(ang)


def apply_rotary(x, cos, sin):
    half = x.shape[-1] // 2
    x1, x2 = x[..., :half], x[..., half:]
    c = cos[None, :, None].astype(x.dtype)
    s = sin[None, :, None].astype(x.dtype)
    return jnp.concatenate([x1 * c - x2 * s, x2 * c + x1 * s], axis=-1)


def diff_qkv(h, w_qkv):
    bsz, L, _ = h.shape
    q, k, v = jnp.split(h @ w_qkv, 3, axis=-1)
    return (q.reshape(bsz, L, 2 * DIFF_HEADS, DIFF_HEAD_DIM),
            k.reshape(bsz, L, 2 * DIFF_HEADS, DIFF_HEAD_DIM),
            v.reshape(bsz, L, DIFF_HEADS, 2 * DIFF_HEAD_DIM))


def diff_lambda(lp, lam_init):
    lp = lp.astype(jnp.float32)
    return jnp.exp(jnp.sum(lp[0] * lp[1])) - jnp.exp(jnp.sum(lp[2] * lp[3])) + lam_init


def block_diff_attention(q, k, v, lam):
    bsz, Lq, H2, d = q.shape
    nb = Lq // Q_BLOCK
    qb = jnp.swapaxes(q.reshape(bsz, nb, Q_BLOCK, H2, d), 0, 1)
    scale = d ** -0.5

    def one_block(qi):
        s = jnp.einsum('bqhd,bkhd->bhqk', qi, k).astype(jnp.float32) * scale
        p = jax.nn.softmax(s, axis=-1).reshape(bsz, H2 // 2, 2, Q_BLOCK, -1)
        att = p[:, :, 0] - lam * p[:, :, 1]
        return jnp.einsum('bhqk,bkhe->bqhe', att.astype(v.dtype), v)

    o = lax.map(one_block, qb)
    return jnp.swapaxes(o, 0, 1).reshape(bsz, Lq, H2 // 2, 2 * d)


def diff_out(o, lam_init, subln_g, w_out):
    bsz, L = o.shape[0], o.shape[1]
    o = rmsnorm(o, subln_g) * (1.0 - lam_init)
    return o.reshape(bsz, L, D_MODEL) @ w_out


def setup_inputs(seed: int = 0) -> dict:
    key = jax.random.key(seed)
    ks = iter(jax.random.split(key, 40))
    f32 = jnp.float32
    D = D_MODEL

    def nrm(shape, scale):
        return jax.random.normal(next(ks), shape, f32) * scale

    def gain(shape):
        return 1.0 + nrm(shape, 0.05)

    x_prompt = nrm((BATCH, SEQ, D), 1.0)
    x_sample = nrm((DEC_BATCH, DEC_SEQ, D), 1.0)
    state_ssm = nrm((DEC_BATCH, N_SSD_LAYERS, 2, SSM_HEADS, SSM_HEAD_DIM, SSM_STATE), 0.3)
    cache_k = nrm((DEC_BATCH, N_DIFF_LAYERS, PAST_LEN, 2 * DIFF_HEADS, DIFF_HEAD_DIM), 1.0)
    cache_v = nrm((DEC_BATCH, N_DIFF_LAYERS, PAST_LEN, DIFF_HEADS, 2 * DIFF_HEAD_DIM), 1.0)
    c = nrm((DEC_BATCH, D), 1.0)
    c_ctx = nrm((D,), 1.0)
    w_mod = nrm((DEPTH, D, 6 * D), 0.5 * D ** -0.5)
    b_mod = nrm((DEPTH, 6 * D), 0.02)
    norm_g = gain((DEPTH, 4, D))
    ssd_w_in = nrm((N_SSD_LAYERS, D, SSM_IN_DIM), D ** -0.5)
    ssd_conv_w = nrm((N_SSD_LAYERS, SSM_CONV, SSM_CONV_DIM), SSM_CONV ** -0.5)
    ssd_conv_b = nrm((N_SSD_LAYERS, SSM_CONV_DIM), 0.02)
    dt0 = jnp.exp(jax.random.uniform(next(ks), (N_SSD_LAYERS, 2, SSM_HEADS), f32,
                                     math.log(1e-3), math.log(1e-1)))
    ssd_dt_bias = dt0 + jnp.log(-jnp.expm1(-dt0))
    ssd_a_log = jnp.log(jax.random.uniform(next(ks), (N_SSD_LAYERS, 2, SSM_HEADS), f32, 1.0, 16.0))
    ssd_d = 1.0 + nrm((N_SSD_LAYERS, SSM_HEADS), 0.1)
    ssd_norm_g = gain((N_SSD_LAYERS, SSM_D_INNER))
    ssd_w_out = nrm((N_SSD_LAYERS, SSM_D_INNER, D), SSM_D_INNER ** -0.5)
    sc_w_in = nrm((N_CONV_LAYERS, D, 3 * D), D ** -0.5)
    sc_conv_w = nrm((N_CONV_LAYERS, SHORT_CONV, D), SHORT_CONV ** -0.5)
    sc_w_out = nrm((N_CONV_LAYERS, D, D), D ** -0.5)
    da_w_qkv = nrm((N_DIFF_LAYERS, D, 3 * D), D ** -0.5)
    da_lambda = nrm((N_DIFF_LAYERS, 4, DIFF_HEAD_DIM), 0.1)
    da_subln_g = gain((N_DIFF_LAYERS, 2 * DIFF_HEAD_DIM))
    da_w_out = nrm((N_DIFF_LAYERS, D, D), D ** -0.5)
    ffn_w_up = nrm((DEPTH, D, 2 * FFN_DIM), D ** -0.5)
    ffn_conv_w = nrm((DEPTH, FFN_CONV, 2 * FFN_DIM), FFN_CONV ** -0.5)
    ffn_w_down = nrm((DEPTH, FFN_DIM, D), FFN_DIM ** -0.5)
    return {'x_prompt': x_prompt, 'x_sample': x_sample, 'state_ssm': state_ssm,
            'cache_k': cache_k, 'cache_v': cache_v, 'c': c, 'c_ctx': c_ctx,
            'w_mod': w_mod, 'b_mod': b_mod, 'norm_g': norm_g,
            'ssd_w_in': ssd_w_in, 'ssd_conv_w': ssd_conv_w, 'ssd_conv_b': ssd_conv_b,
            'ssd_dt_bias': ssd_dt_bias, 'ssd_a_log': ssd_a_log, 'ssd_d': ssd_d,
            'ssd_norm_g': ssd_norm_g, 'ssd_w_out': ssd_w_out,
            'sc_w_in': sc_w_in, 'sc_conv_w': sc_conv_w, 'sc_w_out': sc_w_out,
            'da_w_qkv': da_w_qkv, 'da_lambda': da_lambda, 'da_subln_g': da_subln_g,
            'da_w_out': da_w_out, 'ffn_w_up': ffn_w_up, 'ffn_conv_w': ffn_conv_w,
            'ffn_w_down': ffn_w_down}


def reference(x_prompt, x_sample, state_ssm, cache_k, cache_v, c, c_ctx, w_mod, b_mod, norm_g,
              ssd_w_in, ssd_conv_w, ssd_conv_b, ssd_dt_bias, ssd_a_log, ssd_d, ssd_norm_g, ssd_w_out,
              sc_w_in, sc_conv_w, sc_w_out, da_w_qkv, da_lambda, da_subln_g, da_w_out,
              ffn_w_up, ffn_conv_w, ffn_w_down):
    yp, ys = x_prompt, x_sample
    bp = x_prompt.shape[0]
    cos, sin = axial_rotary(x_sample.shape[1])
    new_ssm, new_k, new_v = [], [], []
    for l in range(DEPTH):
        j = l // N_MIXERS
        kind = l % N_MIXERS
        mod_p = modulation(c_ctx, w_mod[l], b_mod[l])[None, None]
        mod_s = modulation(c, w_mod[l], b_mod[l])[:, None]
        ffn = functools.partial(conv_ffn, w_up=ffn_w_up[l], conv_w=ffn_conv_w[l], w_down=ffn_w_down[l])
        if kind == 0:
            ssd_args = (ssd_w_in[j], ssd_conv_w[j], ssd_conv_b[j], ssd_dt_bias[j], ssd_a_log[j],
                        ssd_d[j], ssd_norm_g[j], ssd_w_out[j])
            zeros = jnp.zeros((bp, 2, SSM_HEADS, SSM_HEAD_DIM, SSM_STATE), jnp.float32)
            mix_p = lambda h: ssd_mixer(h, zeros, *ssd_args)
            mix_s = lambda h: ssd_mixer(h, state_ssm[:, j], *ssd_args)
        elif kind == 1:
            mix_p = functools.partial(short_conv_mixer, w_in=sc_w_in[j], conv_w=sc_conv_w[j], w_out=sc_w_out[j])
            mix_s = mix_p
        else:
            lam_init = 0.8 - 0.6 * math.exp(-0.3 * l)
            lam = diff_lambda(da_lambda[j], lam_init)
            w_qkv, g_sub, w_o = da_w_qkv[j], da_subln_g[j], da_w_out[j]

            def mix_p(h):
                q, k, v = diff_qkv(h, w_qkv)
                return diff_out(block_diff_attention(q, k, v, lam), lam_init, g_sub, w_o), (k, v)

            def mix_s(h):
                q, k, v = diff_qkv(h, w_qkv)
                q = apply_rotary(q, cos, sin)
                k = apply_rotary(k, cos, sin)
                k_all = jnp.concatenate([cache_k[:, j].astype(k.dtype), k], axis=1)
                v_all = jnp.concatenate([cache_v[:, j].astype(v.dtype), v], axis=1)
                return diff_out(block_diff_attention(q, k_all, v_all, lam), lam_init, g_sub, w_o), None

        yp, aux = sandwich_layer(yp, mod_p, norm_g[l], mix_p, ffn)
        ys, _ = sandwich_layer(ys, mod_s, norm_g[l], mix_s, ffn)
        if kind == 0:
            new_ssm.append(aux.astype(x_prompt.dtype))
        elif kind == 2:
            new_k.append(aux[0])
            new_v.append(aux[1])
    new_state_ssm = jnp.stack(new_ssm, axis=1)
    new_cache_k = jnp.stack(new_k, axis=1)
    new_cache_v = jnp.stack(new_v, axis=1)
    return (yp, ys, new_state_ssm, new_cache_k, new_cache_v)
```

```cpp
#include <hip/hip_runtime.h>
#include <hip/hip_cooperative_groups.h>
#include <cstdio>
namespace cg = cooperative_groups;

#define DI __device__ __forceinline__
typedef unsigned short bf16_t;
using bf16x8 = __attribute__((ext_vector_type(8))) short;
using f32x16 = __attribute__((ext_vector_type(16))) float;
typedef __bf16 bf2_t __attribute__((ext_vector_type(2)));
typedef float f2_t __attribute__((ext_vector_type(2)));
typedef unsigned u32x4 __attribute__((ext_vector_type(4)));
typedef unsigned u32x2 __attribute__((ext_vector_type(2)));
typedef float f32x4 __attribute__((ext_vector_type(4)));
#define MFMA(a, b, c) __builtin_amdgcn_mfma_f32_32x32x16_bf16((a), (b), (c), 0, 0, 0)

constexpr int T = 16384, TP = 8192, D = 1024;
constexpr float EPS = 1e-6f;

constexpr size_t al256(size_t x) { return (x + 255) & ~(size_t)255; }
constexpr size_t OFF_MOD = 0;
constexpr size_t OFF_ROT = al256(OFF_MOD + (size_t)4 * 5 * 6144 * 4);
constexpr size_t OFF_RSTD = al256(OFF_ROT + (size_t)2 * 2048 * 32 * 4);
constexpr size_t OFF_DT = al256(OFF_RSTD + (size_t)T * 4);
constexpr size_t OFF_ACST = al256(OFF_DT + (size_t)T * 64 * 4);
constexpr size_t OFF_BST = al256(OFF_ACST + (size_t)128 * 64 * 128 * 4);
constexpr size_t OFF_WST = al256(OFF_BST + (size_t)128 * 64 * 128 * 4);
constexpr size_t OFF_DEC = al256(OFF_WST + (size_t)128 * 64 * 128 * 4);
constexpr size_t OFF_WA = al256(OFF_DEC + (size_t)128 * 64 * 4);
constexpr size_t OFF_WB = al256(OFF_WA + (size_t)6400 * 1024 * 2);
constexpr size_t OFF_WU = al256(OFF_WB + (size_t)1024 * 2048 * 2);
constexpr size_t OFF_WD = al256(OFF_WU + (size_t)5632 * 1024 * 2);
constexpr size_t OFF_H = al256(OFF_WD + (size_t)1024 * 2816 * 2);
constexpr size_t OFF_RA = al256(OFF_H + (size_t)T * 1024 * 2);
constexpr size_t OFF_RB = al256(OFF_RA + (size_t)201326592);
constexpr size_t OFF_BAR = al256(OFF_RB + (size_t)134217728);
constexpr size_t OFF_UE = al256(OFF_BAR + (size_t)3456 * 4);
constexpr size_t WS_NEED = OFF_UE + (size_t)128 * 4 * 5632 * 2;

constexpr size_t OUT_STATE = (size_t)2 * TP * D;
constexpr size_t OUT_CK = OUT_STATE + (size_t)33554432;
constexpr size_t OUT_CV = OUT_CK + (size_t)8388608;

struct Params {
  const float *x_prompt, *x_sample, *state_ssm, *cache_k, *cache_v, *c, *c_ctx, *w_mod, *b_mod, *norm_g;
  const float *ssd_w_in, *ssd_conv_w, *ssd_conv_b, *ssd_dt_bias, *ssd_a_log, *ssd_d, *ssd_norm_g, *ssd_w_out;
  const float *sc_w_in, *sc_conv_w, *sc_w_out, *da_w_qkv, *da_lambda, *da_subln_g, *da_w_out;
  const float *ffn_w_up, *ffn_conv_w, *ffn_w_down;
  float* out;
  char* ws;
};

DI float bf2f(bf16_t v) { return __uint_as_float(((unsigned)v) << 16); }
DI unsigned pk2(float a, float b) { f2_t v = {a, b}; bf2_t r = __builtin_convertvector(v, bf2_t); return __builtin_bit_cast(unsigned, r); }
DI bf16_t f2bf(float a) { return (bf16_t)(pk2(a, 0.f) & 0xffffu); }
DI float lo_f(unsigned u) { return __uint_as_float(u << 16); }
DI float hi_f(unsigned u) { return __uint_as_float(u & 0xffff0000u); }
DI bf16x8 ld8(const bf16_t* p) { return *(const bf16x8*)p; }
DI bf16x8 ld4x2(const bf16_t* p0, const bf16_t* p1) {
  u32x2 a = *(const u32x2*)p0, b = *(const u32x2*)p1;
  u32x4 v = {a.x, a.y, b.x, b.y};
  return __builtin_bit_cast(bf16x8, v);
}
DI bf16x8 pack8(float a0, float a1, float a2, float a3, float a4, float a5, float a6, float a7) {
  u32x4 v = {pk2(a0, a1), pk2(a2, a3), pk2(a4, a5), pk2(a6, a7)};
  return __builtin_bit_cast(bf16x8, v);
}
DI float shx(float v, int mask) {
  int lane = __builtin_amdgcn_mbcnt_hi(-1, __builtin_amdgcn_mbcnt_lo(-1, 0));
  asm volatile("" : "+v"(lane));
  return __builtin_bit_cast(float, __builtin_amdgcn_ds_bpermute((lane ^ mask) << 2, __builtin_bit_cast(int, v)));
}
DI float wave_sum(float v) {
#pragma unroll
  for (int o = 32; o > 0; o >>= 1) v += shx(v, o);
  return v;
}
DI float silu(float x) { return x / (1.f + __expf(-x)); }
DI void zero16(f32x16& a) {
#pragma unroll
  for (int i = 0; i < 16; ++i) a[i] = 0.f;
}
DI int crow(int i, int half) { return (i & 3) + 8 * (i >> 2) + 4 * half; }
DI int otid() { int t = threadIdx.x & 255; asm volatile("" : "+v"(t)); return t; }
DI int obid() { int b = blockIdx.x * 2 + (threadIdx.x >> 8); asm volatile("" : "+v"(b)); return __builtin_amdgcn_readfirstlane(b); }
#define VGRID (gridDim.x * 2)

DI void mod_phase(const float* c_ctx, const float* c_in, const float* w_mod, const float* b_mod, float* MOD, char* smem) {
  float* s = (float*)smem;
  float* red = s + 5 * 1024;
  const int tid = otid();
  for (int it = obid(); it < 4 * 96; it += VGRID) {
    const int l = it / 96, n0 = (it % 96) * 64;
    __syncthreads();
    for (int i = tid; i < 5 * 1024; i += 256) {
      const int c = i >> 10, k = i & 1023;
      const float v = (c == 0) ? c_ctx[k] : c_in[(c - 1) * 1024 + k];
      s[i] = silu(v);
    }
    __syncthreads();
    const int cg = tid & 15, kg = tid >> 4;
    const float* w = w_mod + ((size_t)l * 1024 + kg * 64) * 6144 + n0 + 4 * cg;
    f32x4 a0 = {0.f, 0.f, 0.f, 0.f}, a1 = a0, a2 = a0, a3 = a0, a4 = a0;
#pragma unroll 8
    for (int k = 0; k < 64; ++k) {
      const f32x4 wv = __builtin_nontemporal_load((const f32x4*)(w + (size_t)k * 6144));
      const int kk = kg * 64 + k;
      a0 += s[kk] * wv; a1 += s[1024 + kk] * wv; a2 += s[2048 + kk] * wv; a3 += s[3072 + kk] * wv; a4 += s[4096 + kk] * wv;
    }
    *(f32x4*)(red + (kg * 5 + 0) * 64 + 4 * cg) = a0; *(f32x4*)(red + (kg * 5 + 1) * 64 + 4 * cg) = a1;
    *(f32x4*)(red + (kg * 5 + 2) * 64 + 4 * cg) = a2; *(f32x4*)(red + (kg * 5 + 3) * 64 + 4 * cg) = a3;
    *(f32x4*)(red + (kg * 5 + 4) * 64 + 4 * cg) = a4;
    __syncthreads();
    for (int i = tid; i < 320; i += 256) {
      const int c = i >> 6, cc = i & 63;
      float v = b_mod[l * 6144 + n0 + cc];
#pragma unroll
      for (int g = 0; g < 16; ++g) v += red[(g * 5 + c) * 64 + cc];
      MOD[(size_t)(l * 5 + c) * 6144 + n0 + cc] = v;
    }
  }
}

DI void rot_phase(float* ROTC, float* ROTS) {
  for (int i = obid() * 256 + otid(); i < 2048 * 32; i += VGRID * 256) {
    const int pos = i >> 5, k = i & 31;
    const float inv = powf(10000.f, -(float)(k & 15) / 16.f);
    const float base = (k < 16) ? (float)(pos >> 6) : (float)(pos & 63);
    const float ang = base * inv;
    ROTC[i] = cosf(ang);
    ROTS[i] = sinf(ang);
  }
}

DI int ffn_perm_row(int n) { return n < 2816 ? ((n >> 5) * 64 + (n & 31)) : (((n - 2816) >> 5) * 64 + 32 + ((n - 2816) & 31)); }
DI void convert_wt(const float* __restrict__ src, int K, int N, bf16_t* __restrict__ dst, const float* __restrict__ kscale, char* smem, bool perm = false, int first = -1, int stride = 0) {
  float* tile = (float*)smem;
  const int tid = otid();
  const int tk = K >> 6, tn = N >> 6;
  if (first < 0) { first = obid(); stride = VGRID; }
  for (int it = first; it < tk * tn; it += stride) {
    const int k0 = (it % tk) << 6, n0 = (it / tk) << 6;
    __syncthreads();
#pragma unroll
    for (int ps = 0; ps < 4; ++ps) {
      const int k = (tid >> 4) + 16 * ps, n4 = (tid & 15) * 4;
      const f32x4 v = __builtin_nontemporal_load((const f32x4*)(src + (size_t)(k0 + k) * N + n0 + n4));
      const float sc = kscale ? kscale[k0 + k] : 1.f;
      tile[k * 65 + n4 + 0] = v.x * sc; tile[k * 65 + n4 + 1] = v.y * sc;
      tile[k * 65 + n4 + 2] = v.z * sc; tile[k * 65 + n4 + 3] = v.w * sc;
    }
    __syncthreads();
    const int n = tid >> 2, ks = (tid & 3) * 16;
    unsigned q[8];
#pragma unroll
    for (int j = 0; j < 8; ++j) q[j] = pk2(tile[(ks + 2 * j) * 65 + n], tile[(ks + 2 * j + 1) * 65 + n]);
    const int nrow = perm ? ffn_perm_row(n0 + n) : n0 + n;
    u32x4* d = (u32x4*)(dst + (size_t)nrow * K + k0 + ks);
    u32x4 v0 = {q[0], q[1], q[2], q[3]}, v1 = {q[4], q[5], q[6], q[7]};
    d[0] = v0; d[1] = v1;
  }
}

DI void row_phase(const float* __restrict__ xin_p, const float* __restrict__ xin_s, const bf16_t* __restrict__ f, const float* __restrict__ gate,
                  const float* __restrict__ gprev, float* xout, bf16_t* __restrict__ hout, const float* __restrict__ gn,
                  const float* __restrict__ sh, const float* __restrict__ sc) {
  const int lane = otid() & 63;
  const int wid = obid() * 4 + (otid() >> 6), nw = VGRID * 4;
  for (int t0 = wid * 2; t0 < T; t0 += nw * 2) {
    const int mrow = t0 < TP ? 0 : 1 + ((t0 - TP) >> 11);
    const float* xr = (t0 < TP) ? xin_p + (size_t)t0 * D : xin_s + (size_t)(t0 - TP) * D;
    f32x4 xv[2][4], fv[2][4], gt[4], gp[4], g[4], s1[4], s0[4];
#pragma unroll
    for (int r = 0; r < 2; ++r)
#pragma unroll
      for (int j = 0; j < 4; ++j) xv[r][j] = *(const f32x4*)(xr + (size_t)r * D + lane * 4 + 256 * j);
    if (f) {
#pragma unroll
      for (int r = 0; r < 2; ++r)
#pragma unroll
        for (int j = 0; j < 4; ++j) {
          const u32x2 fr = *(const u32x2*)(f + (size_t)(t0 + r) * D + lane * 4 + 256 * j);
          f32x4 fx = {lo_f(fr.x), hi_f(fr.x), lo_f(fr.y), hi_f(fr.y)};
          fv[r][j] = fx;
        }
#pragma unroll
      for (int j = 0; j < 4; ++j) {
        gt[j] = *(const f32x4*)(gate + (size_t)mrow * 6144 + lane * 4 + 256 * j);
        gp[j] = *(const f32x4*)(gprev + lane * 4 + 256 * j);
      }
    }
    if (hout) {
#pragma unroll
      for (int j = 0; j < 4; ++j) {
        g[j] = *(const f32x4*)(gn + lane * 4 + 256 * j);
        s1[j] = *(const f32x4*)(sc + (size_t)mrow * 6144 + lane * 4 + 256 * j);
        s0[j] = *(const f32x4*)(sh + (size_t)mrow * 6144 + lane * 4 + 256 * j);
      }
    }
    if (f) {
      float q0 = 0.f, q1 = 0.f;
#pragma unroll
      for (int j = 0; j < 4; ++j) {
        q0 += fv[0][j].x * fv[0][j].x + fv[0][j].y * fv[0][j].y + fv[0][j].z * fv[0][j].z + fv[0][j].w * fv[0][j].w;
        q1 += fv[1][j].x * fv[1][j].x + fv[1][j].y * fv[1][j].y + fv[1][j].z * fv[1][j].z + fv[1][j].w * fv[1][j].w;
      }
      q0 = wave_sum(q0); q1 = wave_sum(q1);
      const float r0 = rsqrtf(q0 * (1.f / 1024.f) + EPS), r1 = rsqrtf(q1 * (1.f / 1024.f) + EPS);
#pragma unroll
      for (int j = 0; j < 4; ++j) {
        xv[0][j] += gt[j] * (fv[0][j] * r0 * gp[j]);
        xv[1][j] += gt[j] * (fv[1][j] * r1 * gp[j]);
      }
    }
#pragma unroll
    for (int r = 0; r < 2; ++r)
#pragma unroll
      for (int j = 0; j < 4; ++j) *(f32x4*)(xout + (size_t)(t0 + r) * D + lane * 4 + 256 * j) = xv[r][j];
    if (hout) {
      float q0 = 0.f, q1 = 0.f;
#pragma unroll
      for (int j = 0; j < 4; ++j) {
        q0 += xv[0][j].x * xv[0][j].x + xv[0][j].y * xv[0][j].y + xv[0][j].z * xv[0][j].z + xv[0][j].w * xv[0][j].w;
        q1 += xv[1][j].x * xv[1][j].x + xv[1][j].y * xv[1][j].y + xv[1][j].z * xv[1][j].z + xv[1][j].w * xv[1][j].w;
      }
      q0 = wave_sum(q0); q1 = wave_sum(q1);
      const float rr[2] = {rsqrtf(q0 * (1.f / 1024.f) + EPS), rsqrtf(q1 * (1.f / 1024.f) + EPS)};
#pragma unroll
      for (int r = 0; r < 2; ++r)
#pragma unroll
        for (int j = 0; j < 4; ++j) {
          const f32x4 hv = xv[r][j] * rr[r] * g[j] * (1.f + s1[j]) + s0[j];
          u32x2 o = {pk2(hv.x, hv.y), pk2(hv.z, hv.w)};
          *(u32x2*)(hout + (size_t)(t0 + r) * D + lane * 4 + 256 * j) = o;
        }
    }
  }
}

constexpr int GM = 4;
#define LAS3 __attribute__((address_space(3)))
constexpr int GSTG = 32768;
DI void glds16(const void* gsrc, unsigned lds_dst_uniform) {
  asm volatile("s_mov_b32 m0, %1\n\ts_nop 0\n\tglobal_load_lds_dwordx4 %0, off"
               : : "v"(gsrc), "s"(lds_dst_uniform) : "memory", "m0");
}
template <class Epi>
DI void gemm_phase(const bf16_t* __restrict__ A, int lda, const bf16_t* __restrict__ Bt, int K, int ntn, const Epi& epi, char* smem) {
  int tid = threadIdx.x;
  asm volatile("" : "+v"(tid));
  const int lane = tid & 63, wave = tid >> 6;
  const int wm = (wave >> 2) * 128, wn = (wave & 3) * 64;
  const int l31 = lane & 31, half = lane >> 5;
  const int grow = tid >> 2;
  const int gch = ((tid & 3) ^ ((tid >> 4) & 3)) * 8;
  const int sw = (l31 >> 2) & 3;
  LAS3 char* sm3 = (LAS3 char*)smem;
  const unsigned sbase = (unsigned)(size_t)smem;
  const int offA0 = (wm + l31) * 64 + ((half ^ sw) * 16);
  const int offA1 = (wm + l31) * 64 + (((2 + half) ^ sw) * 16);
  const int offB0 = 16384 + (wn + l31) * 64 + ((half ^ sw) * 16);
  const int offB1 = 16384 + (wn + l31) * 64 + (((2 + half) ^ sw) * 16);
  const int nk = K >> 5;
  int bid = blockIdx.x;
  asm volatile("" : "+v"(bid));
  bid = __builtin_amdgcn_readfirstlane(bid);
  const int xcd = bid & 7, gpx = gridDim.x >> 3;
  for (int idx = bid >> 3; idx < ntn * 8; idx += gpx) {
    const int tm = xcd * 8 + (idx & 7), tn = idx >> 3;
    const bf16_t* Ag = A + (size_t)(tm * 256 + grow) * lda + gch;
    const bf16_t* Bg = Bt + (size_t)(tn * 256 + grow) * K + gch;
    f32x16 acc[GM][2];
#pragma unroll
    for (int i = 0; i < GM; ++i)
#pragma unroll
      for (int j = 0; j < 2; ++j) zero16(acc[i][j]);
#define GISSUE(kt_, stg_)                                                                                         \
    do {                                                                                                          \
      const unsigned d_ = __builtin_amdgcn_readfirstlane(sbase + (stg_) * GSTG + wave * 1024);                    \
      glds16(Ag + (kt_) * 32, d_);                                                                                \
      glds16(Ag + (size_t)128 * lda + (kt_) * 32, d_ + 8192);                                                     \
      glds16(Bg + (kt_) * 32, d_ + 16384);                                                                        \
      glds16(Bg + (size_t)128 * K + (kt_) * 32, d_ + 16384 + 8192);                                               \
    } while (0)
    asm volatile("s_waitcnt vmcnt(0) lgkmcnt(0)" ::: "memory");
    __builtin_amdgcn_s_barrier();
    asm volatile("" ::: "memory");
    GISSUE(0, 0);
    GISSUE(1, 1);
    GISSUE(2, 2);
    bf16x8 pb[2], pa[GM];
    {
      const bf16x8 z8 = {0, 0, 0, 0, 0, 0, 0, 0};
      pb[0] = z8; pb[1] = z8;
#pragma unroll
      for (int mt = 0; mt < GM; ++mt) pa[mt] = z8;
    }
    for (int kt = 0; kt < nk; ++kt) {
      if (kt + 2 < nk) asm volatile("s_waitcnt vmcnt(8) lgkmcnt(0)" ::: "memory");
      else if (kt + 1 < nk) asm volatile("s_waitcnt vmcnt(4) lgkmcnt(0)" ::: "memory");
      else asm volatile("s_waitcnt vmcnt(0) lgkmcnt(0)" ::: "memory");
      __builtin_amdgcn_s_barrier();
      asm volatile("" ::: "memory");
      const int stg = kt & 3, stg3 = (kt + 3) & 3;
      const bool pre = kt + 3 < nk;
      const unsigned gd = __builtin_amdgcn_readfirstlane(sbase + stg3 * GSTG + wave * 1024);
      const bf16_t* Agk = Ag + (kt + 3) * 32;
      const bf16_t* Bgk = Bg + (kt + 3) * 32;
      const LAS3 char* st = sm3 + stg * GSTG;
      bf16x8 fb0[2], fa0[GM];
      fb0[0] = *(const LAS3 bf16x8*)(st + offB0);
      fb0[1] = *(const LAS3 bf16x8*)(st + offB0 + 32 * 64);
#pragma unroll
      for (int mt = 0; mt < GM; ++mt) fa0[mt] = *(const LAS3 bf16x8*)(st + offA0 + mt * 32 * 64);
      if (pre) glds16(Agk, gd);
      __builtin_amdgcn_sched_barrier(0);
#pragma unroll
      for (int mt = 0; mt < GM; ++mt) {
        acc[mt][0] = MFMA(pa[mt], pb[0], acc[mt][0]);
        acc[mt][1] = MFMA(pa[mt], pb[1], acc[mt][1]);
        if (mt == 1) { if (pre) glds16(Agk + (size_t)128 * lda, gd + 8192); __builtin_amdgcn_sched_barrier(0); }
      }
      __builtin_amdgcn_sched_barrier(0);
      pb[0] = *(const LAS3 bf16x8*)(st + offB1);
      pb[1] = *(const LAS3 bf16x8*)(st + offB1 + 32 * 64);
#pragma unroll
      for (int mt = 0; mt < GM; ++mt) pa[mt] = *(const LAS3 bf16x8*)(st + offA1 + mt * 32 * 64);
      __builtin_amdgcn_sched_barrier(0);
#pragma unroll
      for (int mt = 0; mt < GM; ++mt) {
        acc[mt][0] = MFMA(fa0[mt], fb0[0], acc[mt][0]);
        acc[mt][1] = MFMA(fa0[mt], fb0[1], acc[mt][1]);
        if (mt == 0) { if (pre) glds16(Bgk, gd + 16384); __builtin_amdgcn_sched_barrier(0); }
        if (mt == 2) { if (pre) glds16(Bgk + (size_t)128 * K, gd + 16384 + 8192); __builtin_amdgcn_sched_barrier(0); }
      }
    }
#pragma unroll
    for (int mt = 0; mt < GM; ++mt) {
      acc[mt][0] = MFMA(pa[mt], pb[0], acc[mt][0]);
      acc[mt][1] = MFMA(pa[mt], pb[1], acc[mt][1]);
    }
#undef GISSUE
    epi(acc, tm * 256 + wm, tn * 256 + wn, lane);
  }
  asm volatile("s_waitcnt vmcnt(0) lgkmcnt(0)" ::: "memory");
  __syncthreads();
}

struct EpiF32 {
  float* out; int ld; const float* rstd;
  DI void operator()(const f32x16 (&acc)[GM][2], int rbase, int cbase, int lane) const {
    const int l31 = lane & 31, half = lane >> 5;
#pragma unroll
    for (int mt = 0; mt < GM; ++mt)
#pragma unroll
      for (int i = 0; i < 16; ++i) {
        const int row = rbase + 32 * mt + crow(i, half);
        const float s = rstd ? rstd[row] : 1.f;
#pragma unroll
        for (int nt = 0; nt < 2; ++nt) out[(size_t)row * ld + cbase + 32 * nt + l31] = acc[mt][nt][i] * s;
      }
  }
};
struct EpiBF16 {
  bf16_t* out; int ld; const float* rstd;
  DI void operator()(const f32x16 (&acc)[GM][2], int rbase, int cbase, int lane) const {
    const int l31 = lane & 31, half = lane >> 5;
#pragma unroll
    for (int mt = 0; mt < GM; ++mt)
#pragma unroll
      for (int i = 0; i < 16; ++i) {
        const int row = rbase + 32 * mt + crow(i, half);
        const float s = rstd ? rstd[row] : 1.f;
#pragma unroll
        for (int nt = 0; nt < 2; ++nt) out[(size_t)row * ld + cbase + 32 * nt + l31] = f2bf(acc[mt][nt][i] * s);
      }
  }
};
struct EpiSsdIn {
  bf16_t* Z; bf16_t* XBC; float* DT; const float* dt_bias;
  DI void operator()(const f32x16 (&acc)[GM][2], int rbase, int cbase, int lane) const {
    const int l31 = lane & 31, half = lane >> 5;
    if (cbase >= 6208) return;
#pragma unroll
    for (int mt = 0; mt < GM; ++mt)
#pragma unroll
      for (int i = 0; i < 16; ++i) {
        const int row = rbase + 32 * mt + crow(i, half);
#pragma unroll
        for (int nt = 0; nt < 2; ++nt) {
          const int col = cbase + 32 * nt + l31;
          const float v = acc[mt][nt][i];
          if (cbase < 2048) Z[(size_t)row * 2048 + col] = f2bf(v);
          else if (cbase < 6144) XBC[(size_t)row * 4096 + col - 2048] = f2bf(v);
          else {
            const float x = v + dt_bias[col - 6144];
            const float u = __expf(-fabsf(x));
            const float lp = (u < 0.01f) ? u * (1.f - u * (0.5f - u * (1.f / 3.f))) : __logf(1.f + u);
            DT[(size_t)row * 64 + col - 6144] = fmaxf(x, 0.f) + lp;
          }
        }
      }
  }
};
struct EpiQKV {
  bf16_t* Q; bf16_t* KB; bf16_t* VT; float* out_k; float* out_v; const float* ROTC; const float* ROTS;
  DI void operator()(const f32x16 (&acc)[GM][2], int rbase, int cbase, int lane) const {
    const int l31 = lane & 31, half = lane >> 5;
    const bool sample = rbase >= TP;
    if (cbase < 2048) {
      const bool isq = cbase < 1024;
#pragma unroll
      for (int mt = 0; mt < GM; ++mt)
#pragma unroll
        for (int i = 0; i < 16; ++i) {
          const int t = rbase + 32 * mt + crow(i, half);
          float x1 = acc[mt][0][i], x2 = acc[mt][1][i];
          int krow_ = t;
          if (sample) {
            const int pos = (t - TP) & 2047, b = (t - TP) >> 11;
            const float c = ROTC[pos * 32 + l31], s = ROTS[pos * 32 + l31];
            const float o1 = x1 * c - x2 * s, o2 = x2 * c + x1 * s;
            x1 = o1; x2 = o2;
            krow_ = TP + b * 2304 + 256 + pos;
          }
          if (isq) {
            Q[(size_t)t * 1024 + cbase + l31] = f2bf(x1 * 0.125f);
            Q[(size_t)t * 1024 + cbase + 32 + l31] = f2bf(x2 * 0.125f);
          } else {
            const int c0 = cbase - 1024;
            KB[(size_t)krow_ * 1024 + c0 + l31] = f2bf(x1);
            KB[(size_t)krow_ * 1024 + c0 + 32 + l31] = f2bf(x2);
            if (!sample) {
              __builtin_nontemporal_store(x1, out_k + (size_t)t * 1024 + c0 + l31);
              __builtin_nontemporal_store(x2, out_k + (size_t)t * 1024 + c0 + 32 + l31);
            }
          }
        }
    } else {
      const int c0 = cbase - 2048;
#pragma unroll
      for (int mt = 0; mt < GM; ++mt)
#pragma unroll
        for (int qd = 0; qd < 4; ++qd) {
          const int t = rbase + 32 * mt + 8 * qd + 4 * half;
          size_t vb; int L, key;
          if (sample) { const int b = (t - TP) >> 11; vb = (size_t)TP * 1024 + (size_t)b * 1024 * 2304; L = 2304; key = 256 + ((t - TP) & 2047); }
          else { const int s = t >> 8; vb = (size_t)s * 1024 * 256; L = 256; key = t & 255; }
#pragma unroll
          for (int nt = 0; nt < 2; ++nt) {
            const int c = c0 + 32 * nt + l31;
            const float v0 = acc[mt][nt][4 * qd + 0], v1 = acc[mt][nt][4 * qd + 1], v2 = acc[mt][nt][4 * qd + 2], v3 = acc[mt][nt][4 * qd + 3];
            u32x2 o = {pk2(v0, v1), pk2(v2, v3)};
            *(u32x2*)(VT + vb + (size_t)c * L + key) = o;
            if (!sample) {
              __builtin_nontemporal_store(v0, out_v + (size_t)(t + 0) * 1024 + c); __builtin_nontemporal_store(v1, out_v + (size_t)(t + 1) * 1024 + c);
              __builtin_nontemporal_store(v2, out_v + (size_t)(t + 2) * 1024 + c); __builtin_nontemporal_store(v3, out_v + (size_t)(t + 3) * 1024 + c);
            }
          }
        }
    }
  }
};

struct EpiGate {
  bf16_t* G; bf16_t* UE; const float* cw;
  DI void operator()(const f32x16 (&acc)[GM][2], int rbase, int cbase, int lane) const {
    const int l31 = lane & 31, half = lane >> 5;
    const int ch = (cbase >> 6) * 32 + l31;
    const float w0g = cw[ch], w1g = cw[5632 + ch], w2g = cw[11264 + ch];
    const float w0v = cw[2816 + ch], w1v = cw[5632 + 2816 + ch], w2v = cw[11264 + 2816 + ch];
    const int wt = rbase >> 7;
    {
      bf16_t* ue = UE + (size_t)wt * 4 * 5632 + cbase + l31;
      if (half == 0) {
        ue[0] = f2bf(acc[0][0][0]); ue[32] = f2bf(acc[0][1][0]);
        ue[5632] = f2bf(acc[0][0][1]); ue[5632 + 32] = f2bf(acc[0][1][1]);
      } else {
        ue[2 * 5632] = f2bf(acc[3][0][14]); ue[2 * 5632 + 32] = f2bf(acc[3][1][14]);
        ue[3 * 5632] = f2bf(acc[3][0][15]); ue[3 * 5632 + 32] = f2bf(acc[3][1][15]);
      }
    }
    bf16_t* gp = G + (size_t)(rbase + 4 * half) * 2816 + ch;
    float g3prev = 0.f, v3prev = 0.f, g0cur = shx(acc[0][0][0], 32), v0cur = shx(acc[0][1][0], 32);
#pragma unroll
    for (int mq = 0; mq < 16; ++mq) {
      const int mt = mq >> 2, q = mq & 3;
      const float g3cur = shx(acc[mt][0][4 * q + 3], 32), v3cur = shx(acc[mt][1][4 * q + 3], 32);
      const float g0next = (mq < 15) ? shx(acc[(mq + 1) >> 2][0][4 * ((mq + 1) & 3)], 32) : 0.f;
      const float v0next = (mq < 15) ? shx(acc[(mq + 1) >> 2][1][4 * ((mq + 1) & 3)], 32) : 0.f;
#pragma unroll
      for (int e = 0; e < 4; ++e) {
        float pg, pv, ng, nv;
        if (e > 0) { pg = acc[mt][0][4 * q + e - 1]; pv = acc[mt][1][4 * q + e - 1]; }
        else { pg = half ? g3cur : g3prev; pv = half ? v3cur : v3prev; }
        if (e < 3) { ng = acc[mt][0][4 * q + e + 1]; nv = acc[mt][1][4 * q + e + 1]; }
        else { ng = half ? g0next : g0cur; nv = half ? v0next : v0cur; }
        const float gg = w0g * pg + w1g * acc[mt][0][4 * q + e] + w2g * ng;
        const float vv = w0v * pv + w1v * acc[mt][1][4 * q + e] + w2v * nv;
        gp[(size_t)(32 * mt + 8 * q + e) * 2816] = f2bf(silu(gg) * vv);
      }
      g3prev = g3cur; v3prev = v3cur; g0cur = g0next; v0cur = v0next;
    }
  }
};

struct EpiSsdIn2 {
  bf16_t* Z; bf16_t* XT; bf16_t* Bm; bf16_t* Cm; bf16_t* UE; float* DT; const float* dt_bias; const float* cw; const float* cb;
  DI void operator()(const f32x16 (&acc)[GM][2], int rbase, int cbase, int lane) const {
    const int l31 = lane & 31, half = lane >> 5;
    if (cbase >= 6208) return;
    if (cbase < 2048) {
#pragma unroll
      for (int mt = 0; mt < GM; ++mt)
#pragma unroll
        for (int i = 0; i < 16; ++i) {
          const int row = rbase + 32 * mt + crow(i, half);
#pragma unroll
          for (int nt = 0; nt < 2; ++nt) Z[(size_t)row * 2048 + cbase + 32 * nt + l31] = f2bf(acc[mt][nt][i]);
        }
      return;
    }
    if (cbase >= 6144) {
#pragma unroll
      for (int mt = 0; mt < GM; ++mt)
#pragma unroll
        for (int i = 0; i < 16; ++i) {
          const int row = rbase + 32 * mt + crow(i, half);
#pragma unroll
          for (int nt = 0; nt < 2; ++nt) {
            const int col = cbase + 32 * nt + l31;
            const float x = acc[mt][nt][i] + dt_bias[col - 6144];
            const float u = __expf(-fabsf(x));
            const float lp = (u < 0.01f) ? u * (1.f - u * (0.5f - u * (1.f / 3.f))) : __logf(1.f + u);
            DT[(size_t)row * 64 + col - 6144] = fmaxf(x, 0.f) + lp;
          }
        }
      return;
    }
    const int chunk = rbase >> 7;
#pragma unroll
    for (int nt = 0; nt < 2; ++nt) {
      const int cc = cbase - 2048 + 32 * nt + l31;
      const float w0 = cw[cc], w1 = cw[4096 + cc], w2 = cw[8192 + cc], bb = cb[cc];
      {
        bf16_t* ue = UE + (size_t)chunk * 4 * 4096 + cc;
        if (half == 0) { ue[0] = f2bf(acc[0][nt][0]); ue[4096] = f2bf(acc[0][nt][1]); }
        else { ue[2 * 4096] = f2bf(acc[3][nt][14]); ue[3 * 4096] = f2bf(acc[3][nt][15]); }
      }
      float r3prev = 0.f, r0cur = shx(acc[0][nt][0], 32);
#pragma unroll
      for (int mq = 0; mq < 16; ++mq) {
        const int mt = mq >> 2, q = mq & 3;
        const float r3cur = shx(acc[mt][nt][4 * q + 3], 32);
        const float r0next = (mq < 15) ? shx(acc[(mq + 1) >> 2][nt][4 * ((mq + 1) & 3)], 32) : 0.f;
        float o[4];
#pragma unroll
        for (int e = 0; e < 4; ++e) {
          float pv, nv;
          if (e > 0) pv = acc[mt][nt][4 * q + e - 1];
          else pv = half ? r3cur : r3prev;
          if (e < 3) nv = acc[mt][nt][4 * q + e + 1];
          else nv = half ? r0next : r0cur;
          o[e] = silu(bb + w0 * pv + w1 * acc[mt][nt][4 * q + e] + w2 * nv);
        }
        r3prev = r3cur; r0cur = r0next;
        const int R0 = 32 * mt + 8 * q + 4 * half;
        if (cbase < 4096) {
          u32x2 v = {pk2(o[0], o[1]), pk2(o[2], o[3])};
          *(u32x2*)(XT + ((size_t)chunk * 2048 + cc) * 128 + R0) = v;
        } else {
          bf16_t* dst = (cbase < 5120) ? (Bm + (size_t)(rbase + R0) * 1024 + cc - 2048) : (Cm + (size_t)(rbase + R0) * 1024 + cc - 3072);
          dst[0] = f2bf(o[0]); dst[1024] = f2bf(o[1]); dst[2048] = f2bf(o[2]); dst[3072] = f2bf(o[3]);
        }
      }
    }
  }
};

DI bool has_prev(int t) { return t < TP ? (t & 255) != 0 : ((t - TP) & 2047) != 0; }
DI bool has_next(int t) { return t < TP ? (t & 255) != 255 : ((t - TP) & 2047) != 2047; }

DI void unpack8(const u32x4& v, float* o) {
  o[0] = lo_f(v.x); o[1] = hi_f(v.x); o[2] = lo_f(v.y); o[3] = hi_f(v.y);
  o[4] = lo_f(v.z); o[5] = hi_f(v.z); o[6] = lo_f(v.w); o[7] = hi_f(v.w);
}

DI void ssd_conv_phase(const bf16_t* __restrict__ XBC, const float* __restrict__ cw, const float* __restrict__ cb,
                       bf16_t* __restrict__ XT, bf16_t* __restrict__ Bm, bf16_t* __restrict__ Cm) {
  const int tid = otid();
  for (int it = obid(); it < 128 * 32; it += VGRID) {
    const int chunk = it >> 5, c = ((it & 31) << 6) + (tid & 63), sg = tid >> 6;
    const int t0 = chunk * 128 + sg * 32;
    const float w0 = cw[c], w1 = cw[4096 + c], w2 = cw[8192 + c], bb = cb[c];
    float prev = has_prev(t0) ? bf2f(XBC[(size_t)(t0 - 1) * 4096 + c]) : 0.f;
    float cur = bf2f(XBC[(size_t)t0 * 4096 + c]);
#pragma unroll
    for (int s8 = 0; s8 < 4; ++s8) {
      float o[8];
#pragma unroll
      for (int j = 0; j < 8; ++j) {
        const int t = t0 + s8 * 8 + j;
        const float nxt = has_next(t) ? bf2f(XBC[(size_t)(t + 1) * 4096 + c]) : 0.f;
        o[j] = silu(bb + w0 * prev + w1 * cur + w2 * nxt);
        prev = cur; cur = nxt;
      }
      u32x4 v = {pk2(o[0], o[1]), pk2(o[2], o[3]), pk2(o[4], o[5]), pk2(o[6], o[7])};
      *(u32x4*)(XT + ((size_t)chunk * 2048 + c) * 128 + sg * 32 + s8 * 8) = v;
    }
  }
  for (int i = obid() * 256 + tid; i < (T / 4) * 256; i += VGRID * 256) {
    const int t0 = (i >> 8) * 4, c8 = (i & 255) * 8;
    const int c = 2048 + c8;
    const bool hp = has_prev(t0), hn = has_next(t0 + 3);
    const u32x4 zero4 = {0u, 0u, 0u, 0u};
    u32x4 rr[6];
#pragma unroll
    for (int r = 0; r < 6; ++r) {
      const bool valid = (r == 0) ? hp : (r == 5) ? hn : true;
      rr[r] = valid ? *(const u32x4*)(XBC + (size_t)(t0 - 1 + r) * 4096 + c) : zero4;
    }
    float w0[8], w1[8], w2[8], bb[8];
    {
      const f32x4 a0 = *(const f32x4*)(cw + c), a1 = *(const f32x4*)(cw + c + 4);
      const f32x4 b0 = *(const f32x4*)(cw + 4096 + c), b1 = *(const f32x4*)(cw + 4096 + c + 4);
      const f32x4 c0 = *(const f32x4*)(cw + 8192 + c), c1 = *(const f32x4*)(cw + 8192 + c + 4);
      const f32x4 d0 = *(const f32x4*)(cb + c), d1 = *(const f32x4*)(cb + c + 4);
      w0[0] = a0.x; w0[1] = a0.y; w0[2] = a0.z; w0[3] = a0.w; w0[4] = a1.x; w0[5] = a1.y; w0[6] = a1.z; w0[7] = a1.w;
      w1[0] = b0.x; w1[1] = b0.y; w1[2] = b0.z; w1[3] = b0.w; w1[4] = b1.x; w1[5] = b1.y; w1[6] = b1.z; w1[7] = b1.w;
      w2[0] = c0.x; w2[1] = c0.y; w2[2] = c0.z; w2[3] = c0.w; w2[4] = c1.x; w2[5] = c1.y; w2[6] = c1.z; w2[7] = c1.w;
      bb[0] = d0.x; bb[1] = d0.y; bb[2] = d0.z; bb[3] = d0.w; bb[4] = d1.x; bb[5] = d1.y; bb[6] = d1.z; bb[7] = d1.w;
    }
#pragma unroll
    for (int k = 0; k < 4; ++k) {
      float xp[8], xc[8], xn[8], o[8];
      unpack8(rr[k], xp); unpack8(rr[k + 1], xc); unpack8(rr[k + 2], xn);
#pragma unroll
      for (int j = 0; j < 8; ++j) o[j] = silu(bb[j] + w0[j] * xp[j] + w1[j] * xc[j] + w2[j] * xn[j]);
      u32x4 v = {pk2(o[0], o[1]), pk2(o[2], o[3]), pk2(o[4], o[5]), pk2(o[6], o[7])};
      if (c8 < 1024) *(u32x4*)(Bm + (size_t)(t0 + k) * 1024 + c8) = v;
      else *(u32x4*)(Cm + (size_t)(t0 + k) * 1024 + c8 - 1024) = v;
    }
  }
}

DI void ssd_fix_phase(const bf16_t* __restrict__ UE, const float* __restrict__ cw, const float* __restrict__ cb,
                      bf16_t* __restrict__ XT, bf16_t* __restrict__ Bm, bf16_t* __restrict__ Cm) {
  for (int i = obid() * 256 + otid(); i < 128 * 2 * 512; i += VGRID * 256) {
    const int cc = (i & 511) * 8, k = (i >> 9) & 1, chunk = i >> 10;
    const int s = k ? 127 : 0, t = chunk * 128 + s;
    const bf16_t* base = UE + (size_t)chunk * 4 * 4096 + cc;
    const u32x4 zero4 = {0u, 0u, 0u, 0u};
    u32x4 pv, cv, nv;
    if (k == 0) {
      pv = has_prev(t) ? *(const u32x4*)(base - 4096) : zero4;
      cv = *(const u32x4*)base; nv = *(const u32x4*)(base + 4096);
    } else {
      pv = *(const u32x4*)(base + 2 * 4096); cv = *(const u32x4*)(base + 3 * 4096);
      nv = has_next(t) ? *(const u32x4*)(base + 4 * 4096) : zero4;
    }
    float xp[8], xc[8], xn[8], o[8];
    unpack8(pv, xp); unpack8(cv, xc); unpack8(nv, xn);
#pragma unroll
    for (int j = 0; j < 8; ++j) o[j] = silu(cb[cc + j] + cw[cc + j] * xp[j] + cw[4096 + cc + j] * xc[j] + cw[8192 + cc + j] * xn[j]);
    if (cc < 2048) {
#pragma unroll
      for (int j = 0; j < 8; ++j) XT[((size_t)chunk * 2048 + cc + j) * 128 + s] = f2bf(o[j]);
    } else {
      u32x4 v = {pk2(o[0], o[1]), pk2(o[2], o[3]), pk2(o[4], o[5]), pk2(o[6], o[7])};
      if (cc < 3072) *(u32x4*)(Bm + (size_t)t * 1024 + cc - 2048) = v;
      else *(u32x4*)(Cm + (size_t)t * 1024 + cc - 3072) = v;
    }
  }
}

DI void ssd_cumsum_phase(const float* __restrict__ DT, const float* __restrict__ a_log, float* __restrict__ ACST,
                         float* __restrict__ BST, float* __restrict__ WST, float* __restrict__ DEC) {
  for (int i = obid() * 256 + otid(); i < 128 * 64; i += VGRID * 256) {
    const int chunk = i >> 6, hd = i & 63;
    const float a = -__expf(a_log[hd]);
    const float* dp = DT + (size_t)(chunk * 128) * 64 + hd;
    float tot = 0.f;
#pragma unroll 1
    for (int b = 0; b < 8; ++b) {
      float d[16];
#pragma unroll
      for (int k = 0; k < 16; ++k) d[k] = dp[(size_t)(16 * b + k) * 64];
#pragma unroll
      for (int k = 0; k < 16; ++k) tot += d[k] * a;
    }
    const bool bwd = hd >= 32;
    float run = 0.f;
    float* pa = ACST + (size_t)i * 128; float* pb = BST + (size_t)i * 128; float* pw = WST + (size_t)i * 128;
#pragma unroll 1
    for (int b = 0; b < 8; ++b) {
      float d[16];
#pragma unroll
      for (int k = 0; k < 16; ++k) { const int s = bwd ? 127 - (16 * b + k) : 16 * b + k; d[k] = dp[(size_t)s * 64]; }
#pragma unroll
      for (int k = 0; k < 16; ++k) {
        const int s = bwd ? 127 - (16 * b + k) : 16 * b + k;
        run += d[k] * a;
        pa[s] = run;
        pb[s] = run - __logf(d[k]);
        pw[s] = __expf(tot - run) * d[k];
      }
    }
    DEC[i] = __expf(tot);
  }
}

DI void ssd_states_phase(const bf16_t* __restrict__ XT, const bf16_t* __restrict__ Bm, const float* __restrict__ WST,
                         bf16_t* __restrict__ S, char* smem) {
  bf16_t* sBT = (bf16_t*)smem;
  const int tid = otid(), lane = tid & 63, w = tid >> 6, l31 = lane & 31, half = lane >> 5;
  for (int it = obid(); it < 1024; it += VGRID) {
    const int chunk = it >> 3, g = it & 7, t0 = chunk * 128;
    __syncthreads();
#pragma unroll 2
    for (int idx = tid; idx < 128 * 16; idx += 256) {
      const int s = idx >> 4, n8 = (idx & 15) * 8;
      const u32x4 v = *(const u32x4*)(Bm + (size_t)(t0 + s) * 1024 + g * 128 + n8);
      bf16_t* dp = sBT + n8 * 136 + s;
      dp[0 * 136] = (bf16_t)(v.x & 0xffff); dp[1 * 136] = (bf16_t)(v.x >> 16);
      dp[2 * 136] = (bf16_t)(v.y & 0xffff); dp[3 * 136] = (bf16_t)(v.y >> 16);
      dp[4 * 136] = (bf16_t)(v.z & 0xffff); dp[5 * 136] = (bf16_t)(v.z >> 16);
      dp[6 * 136] = (bf16_t)(v.w & 0xffff); dp[7 * 136] = (bf16_t)(v.w >> 16);
    }
    __syncthreads();
    const int h = g * 4 + w;
    u32x4 xa[2][8];
    const bf16_t* xbase = XT + ((size_t)chunk * 2048 + h * 64 + l31) * 128 + 8 * half;
#pragma unroll
    for (int mt = 0; mt < 2; ++mt)
#pragma unroll
      for (int ks = 0; ks < 8; ++ks) xa[mt][ks] = *(const u32x4*)(xbase + mt * 32 * 128 + 16 * ks);
    const bf16_t* bbase = sBT + l31 * 136 + 8 * half;
#pragma unroll 1
    for (int dn = 0; dn < 4; ++dn) {
      const int d = dn >> 1, nh = dn & 1;
      const int hd = d * 32 + h;
      f32x16 acc[2][2];
#pragma unroll
      for (int i = 0; i < 2; ++i)
#pragma unroll
        for (int j = 0; j < 2; ++j) zero16(acc[i][j]);
      const float* wp = WST + ((size_t)chunk * 64 + hd) * 128 + 8 * half;
      const bf16_t* bb = bbase + (64 * nh) * 136;
#pragma unroll
      for (int ks = 0; ks < 8; ++ks) {
        const f32x4 w0 = *(const f32x4*)(wp + 16 * ks);
        const f32x4 w1 = *(const f32x4*)(wp + 16 * ks + 4);
        bf16x8 a[2];
#pragma unroll
        for (int mt = 0; mt < 2; ++mt) {
          const u32x4 xv = xa[mt][ks];
          a[mt] = pack8(lo_f(xv.x) * w0.x, hi_f(xv.x) * w0.y, lo_f(xv.y) * w0.z, hi_f(xv.y) * w0.w,
                        lo_f(xv.z) * w1.x, hi_f(xv.z) * w1.y, lo_f(xv.w) * w1.z, hi_f(xv.w) * w1.w);
        }
#pragma unroll
        for (int nt = 0; nt < 2; ++nt) {
          const bf16x8 b = ld8(bb + (32 * nt) * 136 + 16 * ks);
          acc[0][nt] = MFMA(a[0], b, acc[0][nt]);
          acc[1][nt] = MFMA(a[1], b, acc[1][nt]);
        }
      }
      bf16_t* sp = S + (((size_t)chunk * 2 + d) * 32 + h) * 8192 + (4 * half) * 128 + 64 * nh + l31;
#pragma unroll
      for (int mt = 0; mt < 2; ++mt)
#pragma unroll
        for (int nt = 0; nt < 2; ++nt)
#pragma unroll
          for (int i = 0; i < 16; ++i) sp[(32 * mt + (i & 3) + 8 * (i >> 2)) * 128 + 32 * nt] = f2bf(acc[mt][nt][i]);
    }
  }
}

template <int NC>
DI void scan_item(bf16_t* __restrict__ S, const float* __restrict__ DEC, float (&hc)[8], int cbase, int d, int h, int pp, int n8) {
  u32x4 v[NC];
  float dec[NC];
#pragma unroll
  for (int ci = 0; ci < NC; ++ci) {
    const int chunk = cbase + (d == 0 ? ci : NC - 1 - ci);
    v[ci] = *(const u32x4*)(S + ((((size_t)chunk * 2 + d) * 32 + h) * 64 + pp) * 128 + n8);
    dec[ci] = DEC[chunk * 64 + d * 32 + h];
  }
#pragma unroll
  for (int ci = 0; ci < NC; ++ci) {
    const int chunk = cbase + (d == 0 ? ci : NC - 1 - ci);
    float tmp[8];
    unpack8(v[ci], tmp);
    u32x4 o = {pk2(hc[0], hc[1]), pk2(hc[2], hc[3]), pk2(hc[4], hc[5]), pk2(hc[6], hc[7])};
    *(u32x4*)(S + ((((size_t)chunk * 2 + d) * 32 + h) * 64 + pp) * 128 + n8) = o;
#pragma unroll
    for (int q = 0; q < 8; ++q) hc[q] = hc[q] * dec[ci] + tmp[q];
  }
}
DI void ssd_scan_phase(bf16_t* __restrict__ S, const float* __restrict__ DEC, const float* __restrict__ state_ssm, int j, float* __restrict__ out_state) {
  for (int idx = obid() * 256 + otid(); idx < 36 * 65536; idx += VGRID * 256) {
    const int n8 = (idx & 15) * 8, pp = (idx >> 4) & 63, h = (idx >> 10) & 31, d = (idx >> 15) & 1, seq = idx >> 16;
    float hc[8];
    if (seq < 32) {
      float zz = 0.f;
      asm volatile("" : "+v"(zz));
#pragma unroll
      for (int q = 0; q < 8; ++q) hc[q] = zz;
      scan_item<2>(S, DEC, hc, seq * 2, d, h, pp, n8);
      float* op = out_state + ((((size_t)seq * 2 + j) * 2 + d) * 32 + h) * 8192 + pp * 128 + n8;
      f32x4 a = {hc[0], hc[1], hc[2], hc[3]}, b = {hc[4], hc[5], hc[6], hc[7]};
      __builtin_nontemporal_store(a, (f32x4*)op); __builtin_nontemporal_store(b, (f32x4*)(op + 4));
    } else {
      const float* sp = state_ssm + ((((size_t)(seq - 32) * 2 + j) * 2 + d) * 32 + h) * 8192 + pp * 128 + n8;
      const f32x4 a = *(const f32x4*)sp, b = *(const f32x4*)(sp + 4);
      hc[0] = a.x; hc[1] = a.y; hc[2] = a.z; hc[3] = a.w; hc[4] = b.x; hc[5] = b.y; hc[6] = b.z; hc[7] = b.w;
      scan_item<16>(S, DEC, hc, 64 + (seq - 32) * 16, d, h, pp, n8);
    }
  }
}

DI void ssd_y_phase(const bf16_t* __restrict__ XT, const bf16_t* __restrict__ Bm, const bf16_t* __restrict__ Cm, const bf16_t* __restrict__ S,
                    const float* __restrict__ ACST, const float* __restrict__ BST, const float* __restrict__ dskip, bf16_t* Z, char* smem) {
  constexpr int RS = 272;
  constexpr int TB = 64 * RS;
  const int tid = otid(), lane = tid & 63, w = tid >> 6, l31 = lane & 31, half = lane >> 5;
  for (int it = obid(); it < 1024; it += VGRID) {
    const int chunk = it >> 3, g = it & 7, t0 = chunk * 128;
    const int qc = 32 * w + l31;
    bf16x8 cmf[8];
    {
      const bf16_t* cp = Cm + (size_t)(t0 + qc) * 1024 + g * 128 + 8 * half;
#pragma unroll
      for (int ks = 0; ks < 8; ++ks) cmf[ks] = ld8(cp + 16 * ks);
    }
    f32x16 cbt[4];
#pragma unroll
    for (int mt = 0; mt < 4; ++mt) zero16(cbt[mt]);
    {
      const bf16_t* bp = Bm + (size_t)(t0 + l31) * 1024 + g * 128 + 8 * half;
#pragma unroll
      for (int ks = 0; ks < 8; ++ks) {
#pragma unroll
        for (int mt = 0; mt < 4; ++mt) {
          const bf16x8 a = ld8(bp + (size_t)(32 * mt) * 1024 + 16 * ks);
          cbt[mt] = MFMA(a, cmf[ks], cbt[mt]);
        }
      }
    }
#pragma unroll 1
    for (int r = 0; r < 4; ++r) {
      const int h = g * 4 + r;
      __syncthreads();
      {
        const bf16_t* src0 = XT + ((size_t)chunk * 2048 + h * 64) * 128;
        const bf16_t* src1 = S + (((size_t)chunk * 2 + 0) * 32 + h) * 8192;
        const bf16_t* src2 = S + (((size_t)chunk * 2 + 1) * 32 + h) * 8192;
        u32x4 v0[4], v1[4], v2[4];
#pragma unroll
        for (int i = 0; i < 4; ++i) {
          const int idx = tid + 256 * i;
          v0[i] = *(const u32x4*)(src0 + idx * 8);
          v1[i] = *(const u32x4*)(src1 + idx * 8);
          v2[i] = *(const u32x4*)(src2 + idx * 8);
        }
#pragma unroll
        for (int i = 0; i < 4; ++i) {
          const int idx = tid + 256 * i;
          char* dp = smem + (idx >> 4) * RS + (idx & 15) * 16;
          *(u32x4*)dp = v0[i];
          *(u32x4*)(dp + TB) = v1[i];
          *(u32x4*)(dp + 2 * TB) = v2[i];
        }
      }
      __syncthreads();
      f32x16 yd[2];
      zero16(yd[0]); zero16(yd[1]);
#pragma unroll 1
      for (int d = 0; d < 2; ++d) {
        const int hd = d * 32 + h;
        const float* acsp = ACST + ((size_t)chunk * 64 + hd) * 128;
        const float* bsp = BST + ((size_t)chunk * 64 + hd) * 128 + 4 * half;
        const float aq = acsp[qc];
        f32x16 yo[2];
        zero16(yo[0]); zero16(yo[1]);
        const char* sp = smem + (1 + d) * TB + l31 * RS + 16 * half;
#pragma unroll
        for (int ks = 0; ks < 8; ++ks) {
#pragma unroll
          for (int nt = 0; nt < 2; ++nt) {
            const bf16x8 bfr = *(const bf16x8*)(sp + (32 * nt) * RS + 32 * ks);
            yo[nt] = MFMA(cmf[ks], bfr, yo[nt]);
          }
        }
#pragma unroll
        for (int qd = 0; qd < 4; ++qd) {
          const f32x4 e4 = *(const f32x4*)(acsp + 32 * w + 8 * qd + 4 * half);
          const float e0 = __expf(e4.x), e1 = __expf(e4.y), e2 = __expf(e4.z), e3 = __expf(e4.w);
#pragma unroll
          for (int nt = 0; nt < 2; ++nt) {
            yd[nt][4 * qd + 0] += e0 * yo[nt][4 * qd + 0]; yd[nt][4 * qd + 1] += e1 * yo[nt][4 * qd + 1];
            yd[nt][4 * qd + 2] += e2 * yo[nt][4 * qd + 2]; yd[nt][4 * qd + 3] += e3 * yo[nt][4 * qd + 3];
          }
        }
        const char* xtp = smem + l31 * RS + 8 * half;
#pragma unroll
        for (int mt = 0; mt < 4; ++mt) {
          const bool need = (d == 0) ? (mt <= w) : (mt >= w);
          if (need) {
#pragma unroll
            for (int ss = 0; ss < 2; ++ss) {
              const int sb = 32 * mt + 16 * ss;
              const f32x4 b0 = *(const f32x4*)(bsp + sb);
              const f32x4 b1 = *(const f32x4*)(bsp + sb + 8);
              const float bsv[8] = {b0.x, b0.y, b0.z, b0.w, b1.x, b1.y, b1.z, b1.w};
              float lv[8];
#pragma unroll
              for (int jj = 0; jj < 8; ++jj) {
                const int s = sb + 4 * half + (jj & 3) + 8 * (jj >> 2);
                const bool ok = (d == 0) ? (s <= qc) : (s >= qc);
                const float arg = ok ? (aq - bsv[jj]) : -1e30f;
                lv[jj] = cbt[mt][8 * ss + jj] * __expf(arg);
              }
              const bf16x8 xa = pack8(lv[0], lv[1], lv[2], lv[3], lv[4], lv[5], lv[6], lv[7]);
#pragma unroll
              for (int nt = 0; nt < 2; ++nt) {
                const char* xp = xtp + (32 * nt) * RS + sb * 2;
                const u32x2 lo = *(const u32x2*)xp, hi = *(const u32x2*)(xp + 16);
                u32x4 xv = {lo.x, lo.y, hi.x, hi.y};
                yd[nt] = MFMA(xa, __builtin_bit_cast(bf16x8, xv), yd[nt]);
              }
            }
          }
        }
      }
      const float dsk = dskip[h];
#pragma unroll
      for (int nt = 0; nt < 2; ++nt) {
        const int c = h * 64 + 32 * nt + l31;
        const char* xq = smem + (32 * nt + l31) * RS + (32 * w + 4 * half) * 2;
        bf16_t* zp = Z + (size_t)(t0 + 32 * w + 4 * half) * 2048 + c;
#pragma unroll
        for (int qd = 0; qd < 4; ++qd) {
          const u32x2 xv = *(const u32x2*)(xq + 16 * qd);
          const float xs[4] = {lo_f(xv.x), hi_f(xv.x), lo_f(xv.y), hi_f(xv.y)};
#pragma unroll
          for (int e = 0; e < 4; ++e) {
            bf16_t* zz = zp + (size_t)(8 * qd + e) * 2048;
            const float zv = bf2f(*zz);
            const float y = yd[nt][4 * qd + e] + dsk * xs[e];
            *zz = f2bf(y * silu(zv));
          }
        }
      }
    }
  }
  __syncthreads();
}

DI void ssq_phase(const bf16_t* __restrict__ YZ, float* __restrict__ RSTD) {
  const int lane = otid() & 63;
  const int wid = obid() * 4 + (otid() >> 6), nw = VGRID * 4;
  for (int t = wid; t < T; t += nw) {
    float ssq = 0.f;
#pragma unroll
    for (int j = 0; j < 4; ++j) {
      float v[8];
      unpack8(*(const u32x4*)(YZ + (size_t)t * 2048 + lane * 8 + 512 * j), v);
#pragma unroll
      for (int q = 0; q < 8; ++q) ssq += v[q] * v[q];
    }
    ssq = wave_sum(ssq);
    if (lane == 0) RSTD[t] = rsqrtf(ssq * (1.f / 2048.f) + EPS);
  }
}

DI void sc_mid_phase(const bf16_t* __restrict__ BCU, const float* __restrict__ cw, bf16_t* __restrict__ H) {
  for (int i = obid() * 256 + otid(); i < (T / 4) * 128; i += VGRID * 256) {
    const int t0 = (i >> 7) * 4, c = (i & 127) * 8;
    const bool hp = has_prev(t0), hn = has_next(t0 + 3);
    const u32x4 zero4 = {0u, 0u, 0u, 0u};
    u32x4 ar[6], br[6], gr[4];
#pragma unroll
    for (int r = 0; r < 6; ++r) {
      const bool valid = (r == 0) ? hp : (r == 5) ? hn : true;
      const bf16_t* p = BCU + (size_t)(t0 - 1 + r) * 3072 + c;
      ar[r] = valid ? *(const u32x4*)(p + 1024) : zero4;
      br[r] = valid ? *(const u32x4*)(p + 2048) : zero4;
    }
#pragma unroll
    for (int k = 0; k < 4; ++k) gr[k] = *(const u32x4*)(BCU + (size_t)(t0 + k) * 3072 + c);
    float w0[8], w1[8], w2[8];
    {
      const f32x4 a0 = *(const f32x4*)(cw + c), a1 = *(const f32x4*)(cw + c + 4);
      const f32x4 b0 = *(const f32x4*)(cw + 1024 + c), b1 = *(const f32x4*)(cw + 1024 + c + 4);
      const f32x4 c0 = *(const f32x4*)(cw + 2048 + c), c1 = *(const f32x4*)(cw + 2048 + c + 4);
      w0[0] = a0.x; w0[1] = a0.y; w0[2] = a0.z; w0[3] = a0.w; w0[4] = a1.x; w0[5] = a1.y; w0[6] = a1.z; w0[7] = a1.w;
      w1[0] = b0.x; w1[1] = b0.y; w1[2] = b0.z; w1[3] = b0.w; w1[4] = b1.x; w1[5] = b1.y; w1[6] = b1.z; w1[7] = b1.w;
      w2[0] = c0.x; w2[1] = c0.y; w2[2] = c0.z; w2[3] = c0.w; w2[4] = c1.x; w2[5] = c1.y; w2[6] = c1.z; w2[7] = c1.w;
    }
#pragma unroll
    for (int k = 0; k < 4; ++k) {
      float a0[8], b0[8], a1[8], b1[8], a2[8], b2[8], bg[8], o[8];
      unpack8(ar[k], a0); unpack8(br[k], b0); unpack8(ar[k + 1], a1); unpack8(br[k + 1], b1); unpack8(ar[k + 2], a2); unpack8(br[k + 2], b2);
      unpack8(gr[k], bg);
#pragma unroll
      for (int j = 0; j < 8; ++j) o[j] = bg[j] * (w0[j] * (a0[j] * b0[j]) + w1[j] * (a1[j] * b1[j]) + w2[j] * (a2[j] * b2[j]));
      u32x4 v = {pk2(o[0], o[1]), pk2(o[2], o[3]), pk2(o[4], o[5]), pk2(o[6], o[7])};
      *(u32x4*)(H + (size_t)(t0 + k) * 1024 + c) = v;
    }
  }
}

DI void ffn_gate_phase(const bf16_t* __restrict__ U, const float* __restrict__ cw, bf16_t* __restrict__ G) {
  for (int i = obid() * 256 + otid(); i < (T / 4) * 352; i += VGRID * 256) {
    const int tb = i / 352, c = (i - tb * 352) * 8, t0 = tb * 4;
    const bool hp = has_prev(t0), hn = has_next(t0 + 3);
    u32x4 gr[6], vr[6];
    const u32x4 zero4 = {0u, 0u, 0u, 0u};
#pragma unroll
    for (int r = 0; r < 6; ++r) {
      const bool valid = (r == 0) ? hp : (r == 5) ? hn : true;
      const bf16_t* up = U + (size_t)(t0 - 1 + r) * 5632 + c;
      gr[r] = valid ? *(const u32x4*)up : zero4;
      vr[r] = valid ? *(const u32x4*)(up + 2816) : zero4;
    }
    float wg[3][8], wv[3][8];
#pragma unroll
    for (int k = 0; k < 3; ++k) {
      const f32x4 a0 = *(const f32x4*)(cw + k * 5632 + c), a1 = *(const f32x4*)(cw + k * 5632 + c + 4);
      const f32x4 b0 = *(const f32x4*)(cw + k * 5632 + 2816 + c), b1 = *(const f32x4*)(cw + k * 5632 + 2816 + c + 4);
      wg[k][0] = a0.x; wg[k][1] = a0.y; wg[k][2] = a0.z; wg[k][3] = a0.w; wg[k][4] = a1.x; wg[k][5] = a1.y; wg[k][6] = a1.z; wg[k][7] = a1.w;
      wv[k][0] = b0.x; wv[k][1] = b0.y; wv[k][2] = b0.z; wv[k][3] = b0.w; wv[k][4] = b1.x; wv[k][5] = b1.y; wv[k][6] = b1.z; wv[k][7] = b1.w;
    }
#pragma unroll
    for (int k = 0; k < 4; ++k) {
      float g0[8], g1[8], g2[8], v0[8], v1[8], v2[8], o[8];
      unpack8(gr[k], g0); unpack8(gr[k + 1], g1); unpack8(gr[k + 2], g2);
      unpack8(vr[k], v0); unpack8(vr[k + 1], v1); unpack8(vr[k + 2], v2);
#pragma unroll
      for (int j = 0; j < 8; ++j) {
        const float gg = wg[0][j] * g0[j] + wg[1][j] * g1[j] + wg[2][j] * g2[j];
        const float vv = wv[0][j] * v0[j] + wv[1][j] * v1[j] + wv[2][j] * v2[j];
        o[j] = silu(gg) * vv;
      }
      u32x4 ov = {pk2(o[0], o[1]), pk2(o[2], o[3]), pk2(o[4], o[5]), pk2(o[6], o[7])};
      *(u32x4*)(G + (size_t)(t0 + k) * 2816 + c) = ov;
    }
  }
}

DI void ffn_fix_phase(const bf16_t* __restrict__ UE, const float* __restrict__ cw, bf16_t* __restrict__ G,
                      int wt0 = 0, int nwt = 128, int first = -1, int stride = 0) {
  if (first < 0) { first = obid() * 256 + otid(); stride = VGRID * 256; }
  for (int i = first; i < nwt * 2 * 352; i += stride) {
    const int c = (i % 352) * 8, k = (i / 352) & 1, wt = wt0 + i / 704;
    const int t = wt * 128 + (k ? 127 : 0);
    const int pc = (c >> 5) * 64 + (c & 31);
    const bf16_t* base = UE + (size_t)wt * 4 * 5632 + pc;
    const u32x4 zero4 = {0u, 0u, 0u, 0u};
    u32x4 gpv, gcv, gnv, vpv, vcv, vnv;
    if (k == 0) {
      const bool hp = has_prev(t);
      gpv = hp ? *(const u32x4*)(base - 5632) : zero4;
      vpv = hp ? *(const u32x4*)(base - 5632 + 32) : zero4;
      gcv = *(const u32x4*)base; vcv = *(const u32x4*)(base + 32);
      gnv = *(const u32x4*)(base + 5632); vnv = *(const u32x4*)(base + 5632 + 32);
    } else {
      const bool hn = has_next(t);
      gpv = *(const u32x4*)(base + 2 * 5632); vpv = *(const u32x4*)(base + 2 * 5632 + 32);
      gcv = *(const u32x4*)(base + 3 * 5632); vcv = *(const u32x4*)(base + 3 * 5632 + 32);
      gnv = hn ? *(const u32x4*)(base + 4 * 5632) : zero4;
      vnv = hn ? *(const u32x4*)(base + 4 * 5632 + 32) : zero4;
    }
    float gp[8], gc[8], gn[8], vp[8], vc[8], vn[8], o[8];
    unpack8(gpv, gp); unpack8(gcv, gc); unpack8(gnv, gn); unpack8(vpv, vp); unpack8(vcv, vc); unpack8(vnv, vn);
#pragma unroll
    for (int j = 0; j < 8; ++j) {
      const float gg = cw[c + j] * gp[j] + cw[5632 + c + j] * gc[j] + cw[11264 + c + j] * gn[j];
      const float vv = cw[2816 + c + j] * vp[j] + cw[5632 + 2816 + c + j] * vc[j] + cw[11264 + 2816 + c + j] * vn[j];
      o[j] = silu(gg) * vv;
    }
    u32x4 ov = {pk2(o[0], o[1]), pk2(o[2], o[3]), pk2(o[4], o[5]), pk2(o[6], o[7])};
    *(u32x4*)(G + (size_t)t * 2816 + c) = ov;
  }
}

DI void cache_phase(const float* __restrict__ ck, const float* __restrict__ cv, bf16_t* __restrict__ KB, bf16_t* __restrict__ VT) {
  for (int i = obid() * 256 + otid(); i < 4 * 256 * 1024; i += VGRID * 256) {
    const int c = i & 1023, jk = (i >> 10) & 255, b = i >> 18;
    KB[(size_t)(TP + b * 2304 + jk) * 1024 + c] = f2bf(ck[i]);
    VT[(size_t)TP * 1024 + (size_t)b * 1024 * 2304 + (size_t)c * 2304 + jk] = f2bf(cv[i]);
  }
}

DI void attn_phase(const bf16_t* __restrict__ Q, const bf16_t* __restrict__ KB, const bf16_t* __restrict__ VT, bf16_t* __restrict__ O,
                   const float* __restrict__ gsub, float lam, float lam_init, char* smem) {
  constexpr int KRS = 272, VRS = 72;
  constexpr int KB_BYTES = 32 * KRS;
  constexpr int BUF = KB_BYTES + 128 * VRS;
  const int tid = otid(), lane = tid & 63, w = tid >> 6, l31 = lane & 31, half = lane >> 5;
  const int krow0 = tid >> 4, kc = tid & 15;
  const int vrow0 = tid >> 2, vc = tid & 3;
  for (int it = obid(); it < 1024; it += VGRID) {
    int seqt0, kb0, L, hp, qb; size_t vbase;
    if (it < 512) { const int b = it >> 7; hp = (it >> 4) & 7; qb = it & 15; seqt0 = TP + b * 2048; kb0 = TP + b * 2304; L = 2304; vbase = (size_t)TP * 1024 + (size_t)b * 1024 * 2304; }
    else { const int i2 = it - 512; const int s = i2 >> 4; hp = (i2 >> 1) & 7; qb = i2 & 1; seqt0 = s * 256; kb0 = s * 256; L = 256; vbase = (size_t)s * 1024 * 256; }
    const int tq = seqt0 + qb * 128 + w * 32 + l31;
    const int ntile = L >> 5;
    bf16x8 qf0[4], qf1[4];
    {
      const bf16_t* qp = Q + (size_t)tq * 1024 + (2 * hp) * 64 + 8 * half;
#pragma unroll
      for (int ks = 0; ks < 4; ++ks) { qf0[ks] = ld8(qp + 16 * ks); qf1[ks] = ld8(qp + 64 + 16 * ks); }
    }
    const bf16_t* kg = KB + (size_t)(kb0 + krow0) * 1024 + (2 * hp) * 64 + kc * 8;
    const bf16_t* vg = VT + vbase + (size_t)(hp * 128 + vrow0) * L + vc * 8;
    char* kdst = smem + krow0 * KRS + kc * 16;
    char* vdst = smem + KB_BYTES + vrow0 * VRS + vc * 16;
    const char* kfr = smem + l31 * KRS + 16 * half;
    const char* vfr = smem + KB_BYTES + l31 * VRS + 8 * half;

    float m0 = -1e30f, m1 = -1e30f, l0 = 0.f, l1 = 0.f;
#define ATT_QK(s0_, s1_, cur_)                                                              \
    do {                                                                                    \
      zero16(s0_); zero16(s1_);                                                             \
      _Pragma("unroll") for (int ks = 0; ks < 4; ++ks) {                                    \
        const bf16x8 a0 = *(const bf16x8*)(kfr + (cur_) + 32 * ks);                         \
        s0_ = MFMA(a0, qf0[ks], s0_);                                                            \
      }                                                                                     \
      __builtin_amdgcn_sched_barrier(0);                                                    \
      _Pragma("unroll") for (int ks = 0; ks < 4; ++ks) {                                    \
        const bf16x8 a1 = *(const bf16x8*)(kfr + (cur_) + 128 + 32 * ks);                   \
        s1_ = MFMA(a1, qf1[ks], s1_);                                                            \
      }                                                                                     \
      __builtin_amdgcn_sched_barrier(0);                                                    \
    } while (0)
    __syncthreads();
    {
      const u32x4 k0 = *(const u32x4*)kg, k1 = *(const u32x4*)(kg + 16 * 1024);
      *(u32x4*)kdst = k0; *(u32x4*)(kdst + 16 * KRS) = k1;
    }
    __syncthreads();
#pragma unroll 1
    for (int ti = 0; ti < ntile; ++ti) {
      const int cur = (ti & 1) * BUF, nxt = BUF - cur;
      const bool more = ti + 1 < ntile;
      u32x4 k0, k1;
      if (more) {
        const bf16_t* kq = kg + (size_t)(ti + 1) * 32 * 1024;
        k0 = *(const u32x4*)kq; k1 = *(const u32x4*)(kq + 16 * 1024);
      }
      f32x16 s0, s1;
      ATT_QK(s0, s1, cur);
      float x0 = s0[0], x1 = s1[0];
#pragma unroll
      for (int i = 1; i < 16; ++i) { x0 = fmaxf(x0, s0[i]); x1 = fmaxf(x1, s1[i]); }
      const float n0 = fmaxf(m0, x0), n1 = fmaxf(m1, x1);
      float p0 = 0.f, p1 = 0.f;
#pragma unroll
      for (int i = 0; i < 16; ++i) { p0 += __expf(s0[i] - n0); p1 += __expf(s1[i] - n1); }
      l0 = l0 * __expf(m0 - n0) + p0; m0 = n0;
      l1 = l1 * __expf(m1 - n1) + p1; m1 = n1;
      if (more) { *(u32x4*)(kdst + nxt) = k0; *(u32x4*)(kdst + nxt + 16 * KRS) = k1; }
      __syncthreads();
    }
    {
      const float mo0 = shx(m0, 32), lo0 = shx(l0, 32);
      const float mo1 = shx(m1, 32), lo1 = shx(l1, 32);
      const float M0 = fmaxf(m0, mo0), M1 = fmaxf(m1, mo1);
      l0 = l0 * __expf(m0 - M0) + lo0 * __expf(mo0 - M0); m0 = M0;
      l1 = l1 * __expf(m1 - M1) + lo1 * __expf(mo1 - M1); m1 = M1;
    }
    const float c0 = 1.f / l0, c1 = -lam / l1;
    f32x16 o[4];
#pragma unroll
    for (int et = 0; et < 4; ++et) zero16(o[et]);
    {
      const u32x4 k0 = *(const u32x4*)kg, k1 = *(const u32x4*)(kg + 16 * 1024);
      const u32x4 v0 = *(const u32x4*)vg, v1 = *(const u32x4*)(vg + (size_t)64 * L);
      *(u32x4*)kdst = k0; *(u32x4*)(kdst + 16 * KRS) = k1;
      u32x2 a = {v0.x, v0.y}, b = {v0.z, v0.w}, c = {v1.x, v1.y}, d = {v1.z, v1.w};
      *(u32x2*)vdst = a; *(u32x2*)(vdst + 8) = b; *(u32x2*)(vdst + 64 * VRS) = c; *(u32x2*)(vdst + 64 * VRS + 8) = d;
    }
    __syncthreads();
#pragma unroll 1
    for (int ti = 0; ti < ntile; ++ti) {
      const int cur = (ti & 1) * BUF, nxt = BUF - cur;
      const bool more = ti + 1 < ntile;
      u32x4 k0, k1, v0, v1;
      if (more) {
        const bf16_t* kq = kg + (size_t)(ti + 1) * 32 * 1024;
        k0 = *(const u32x4*)kq; k1 = *(const u32x4*)(kq + 16 * 1024);
        const bf16_t* vq = vg + (ti + 1) * 32;
        v0 = *(const u32x4*)vq; v1 = *(const u32x4*)(vq + (size_t)64 * L);
      }
      f32x16 s0, s1;
      ATT_QK(s0, s1, cur);
#pragma unroll
      for (int i = 0; i < 16; ++i) s0[i] = c0 * __expf(s0[i] - m0) + c1 * __expf(s1[i] - m1);
#pragma unroll
      for (int ss = 0; ss < 2; ++ss) {
        const bf16x8 pb = pack8(s0[8 * ss + 0], s0[8 * ss + 1], s0[8 * ss + 2], s0[8 * ss + 3],
                                s0[8 * ss + 4], s0[8 * ss + 5], s0[8 * ss + 6], s0[8 * ss + 7]);
#pragma unroll
        for (int et = 0; et < 4; ++et) {
          const char* vq = vfr + cur + (32 * et) * VRS + 32 * ss;
          const u32x2 lo = *(const u32x2*)vq, hi = *(const u32x2*)(vq + 16);
          u32x4 vv = {lo.x, lo.y, hi.x, hi.y};
          o[et] = MFMA(__builtin_bit_cast(bf16x8, vv), pb, o[et]);
        }
      }
      if (more) {
        *(u32x4*)(kdst + nxt) = k0; *(u32x4*)(kdst + nxt + 16 * KRS) = k1;
        u32x2 a = {v0.x, v0.y}, b = {v0.z, v0.w}, c = {v1.x, v1.y}, d = {v1.z, v1.w};
        *(u32x2*)(vdst + nxt) = a; *(u32x2*)(vdst + nxt + 8) = b;
        *(u32x2*)(vdst + nxt + 64 * VRS) = c; *(u32x2*)(vdst + nxt + 64 * VRS + 8) = d;
      }
      __syncthreads();
    }
#undef ATT_QK
    float ssq = 0.f;
#pragma unroll
    for (int et = 0; et < 4; ++et)
#pragma unroll
      for (int i = 0; i < 16; ++i) ssq += o[et][i] * o[et][i];
    ssq += shx(ssq, 32);
    const float r = rsqrtf(ssq * (1.f / 128.f) + EPS) * (1.f - lam_init);
    bf16_t* op = O + (size_t)tq * 1024 + hp * 128 + 4 * half;
#pragma unroll
    for (int et = 0; et < 4; ++et)
#pragma unroll
      for (int qd = 0; qd < 4; ++qd) {
        const int e = 32 * et + 8 * qd;
        const f32x4 g4 = *(const f32x4*)(gsub + e + 4 * half);
        u32x2 ov = {pk2(o[et][4 * qd + 0] * r * g4.x, o[et][4 * qd + 1] * r * g4.y),
                    pk2(o[et][4 * qd + 2] * r * g4.z, o[et][4 * qd + 3] * r * g4.w)};
        *(u32x2*)(op + e) = ov;
      }
  }
  __syncthreads();
}

typedef __attribute__((address_space(4))) const Params* KParams;
DI KParams PP() {
  KParams k = (KParams)__builtin_amdgcn_kernarg_segment_ptr();
  asm volatile("" : "+s"(k));
  return k;
}
#define XB_TMO      128
#define XB_XCNT(j)  (256  + 64 * (j))
#define XB_XSUB(j)  (1280 + 64 * (j))
#define XB_XGEN(j)  (2304 + 64 * (j))
#define XB_TOP      3328
#define XB_TOPGEN   3392
#define XCD_BAR_WORDS 3456
#define XB_SPIN_CAP (1u << 18)
#define LAS __attribute__((address_space(3)))

__device__ __forceinline__ unsigned xb_ld(unsigned* p)              { return __hip_atomic_load(p, __ATOMIC_RELAXED, __HIP_MEMORY_SCOPE_AGENT); }
__device__ __forceinline__ unsigned xb_add(unsigned* p, unsigned v) { return __hip_atomic_fetch_add(p, v, __ATOMIC_RELAXED, __HIP_MEMORY_SCOPE_AGENT); }
__device__ __forceinline__ unsigned xb_xcc_id() { return (unsigned)__builtin_amdgcn_s_getreg((3 << 11) | 20) & 0xFu; }
#define XB_SPIN(cond, bar) do { unsigned _sp = 0; while (cond) { __builtin_amdgcn_s_sleep(1); \
    if ((++_sp & 255u) == 0u) { if (xb_ld(&(bar)[XB_TMO])) break; if (_sp > XB_SPIN_CAP) { atomicAdd(&(bar)[XB_TMO], 1u); break; } } } } while (0)

struct XcdBarrier {
    unsigned* bar; unsigned x;
    volatile LAS unsigned* st;
};

__device__ __forceinline__ XcdBarrier xcd_barrier_post(unsigned* bar, volatile LAS unsigned* st) {
    XcdBarrier b; b.bar = bar; b.x = xb_xcc_id(); b.st = st;
    if (threadIdx.x == 0) (void)xb_add(&bar[XB_XCNT(b.x)], 1u);
    return b;
}
__device__ __forceinline__ void xcd_barrier_complete(unsigned* bar, unsigned x, unsigned& nloc, unsigned& nx) {
    const unsigned G = gridDim.x * gridDim.y * gridDim.z;
    unsigned sum, cnt, mine, sp = 0u;
    for (;;) {
        sum = 0u; cnt = 0u; mine = 0u;
#pragma unroll
        for (unsigned j = 0; j < 16; ++j) { const unsigned c = xb_ld(&bar[XB_XCNT(j)]); sum += c; cnt += (c > 0u) ? 1u : 0u; mine = (j == x) ? c : mine; }
        if (sum == G) break;
        __builtin_amdgcn_s_sleep(1);
        if ((++sp & 255u) == 0u) { if (xb_ld(&bar[XB_TMO])) break; if (sp > XB_SPIN_CAP) { atomicAdd(&bar[XB_TMO], 1u); break; } }
    }
    nloc = mine > 0u ? mine : 1u; nx = cnt > 0u ? cnt : 1u;
}

__device__ __forceinline__ void xcd_barrier(const XcdBarrier& b) {
    asm volatile("s_waitcnt vmcnt(0)" ::: "memory");
    __syncthreads();
    if (threadIdx.x == 0) {
        unsigned* bar = b.bar;
        __builtin_amdgcn_s_waitcnt(0);
        unsigned nloc = b.st[0], nx = b.st[1];
        if (nloc == 0u) { xcd_barrier_complete(bar, b.x, nloc, nx); b.st[0] = nloc; b.st[1] = nx; }
        const unsigned old = xb_add(&bar[XB_XSUB(b.x)], 1u);
        const unsigned gen = old / nloc;
        if (old + 1u == (gen + 1u) * nloc) {
            __builtin_amdgcn_fence(__ATOMIC_RELEASE, "agent");
            asm volatile("s_waitcnt vmcnt(0)" ::: "memory");
            const unsigned og = xb_add(&bar[XB_TOP], 1u);
            const unsigned tg = og / nx;
            if (og + 1u == (tg + 1u) * nx) xb_add(&bar[XB_TOPGEN], 1u);
            else XB_SPIN(xb_ld(&bar[XB_TOPGEN]) == tg, bar);
            __builtin_amdgcn_fence(__ATOMIC_ACQUIRE, "agent");
            xb_add(&bar[XB_XGEN(b.x)], 1u);
            asm volatile("s_waitcnt vmcnt(0)" ::: "memory");
        } else {
            XB_SPIN(xb_ld(&bar[XB_XGEN(b.x)]) == gen, bar);
            __builtin_amdgcn_fence(__ATOMIC_ACQUIRE, "agent");
            asm volatile("s_waitcnt vmcnt(0)" ::: "memory");
        }
    }
    __syncthreads();
}

#define WSB() (PP()->ws)
#define MOD ((float*)(WSB() + OFF_MOD))
#define ROTC ((float*)(WSB() + OFF_ROT))
#define ROTS ((float*)(WSB() + OFF_ROT) + 2048 * 32)
#define RSTD ((float*)(WSB() + OFF_RSTD))
#define DT ((float*)(WSB() + OFF_DT))
#define ACST ((float*)(WSB() + OFF_ACST))
#define BST ((float*)(WSB() + OFF_BST))
#define WST ((float*)(WSB() + OFF_WST))
#define DEC ((float*)(WSB() + OFF_DEC))
#define WA ((bf16_t*)(WSB() + OFF_WA))
#define WB ((bf16_t*)(WSB() + OFF_WB))
#define WU ((bf16_t*)(WSB() + OFF_WU))
#define WD ((bf16_t*)(WSB() + OFF_WD))
#define H ((bf16_t*)(WSB() + OFF_H))
#define RA (WSB() + OFF_RA)
#define RB (WSB() + OFF_RB)
#define xo (PP()->out)
#define GSYNC() do { XcdBarrier b_; b_.bar = (unsigned*)(WSB() + OFF_BAR); b_.x = xb_xcc_id(); b_.st = (volatile LAS unsigned*)&xb_words; xcd_barrier(b_); } while (0)
#define CONVERT_MIXER(L_, F_, S_)                                                                                             \
  do {                                                                                                                        \
    const int k_ = (L_) % 3, j_ = (L_) / 3;                                                                                   \
    if (k_ == 0) {                                                                                                            \
      convert_wt(PP()->ssd_w_in + (size_t)j_ * 1024 * 6208, 1024, 6208, WA, nullptr, vsm, false, F_, S_);                     \
      convert_wt(PP()->ssd_w_out + (size_t)j_ * 2048 * 1024, 2048, 1024, WB, PP()->ssd_norm_g + j_ * 2048, vsm, false, F_, S_); \
    } else if (k_ == 1) {                                                                                                     \
      convert_wt(PP()->sc_w_in, 1024, 3072, WA, nullptr, vsm, false, F_, S_);                                                 \
      convert_wt(PP()->sc_w_out, 1024, 1024, WB, nullptr, vsm, false, F_, S_);                                                \
    } else {                                                                                                                  \
      convert_wt(PP()->da_w_qkv, 1024, 3072, WA, nullptr, vsm, false, F_, S_);                                                \
      convert_wt(PP()->da_w_out, 1024, 1024, WB, nullptr, vsm, false, F_, S_);                                                \
    }                                                                                                                         \
  } while (0)
#define CONVERT_FFN(L_, F_, S_)                                                                                               \
  do {                                                                                                                        \
    convert_wt(PP()->ffn_w_up + (size_t)(L_) * 1024 * 5632, 1024, 5632, WU, nullptr, vsm, true, F_, S_);                      \
    convert_wt(PP()->ffn_w_down + (size_t)(L_) * 2816 * 1024, 2816, 1024, WD, nullptr, vsm, false, F_, S_);                   \
  } while (0)
#define TAIL_IDLE(NTN_) ((((NTN_) * 8) & 31) != 0 && ((obid() >> 4) >= (((NTN_) * 8) & 31)))
#define TAIL_FIRST(NTN_) ((((obid() >> 4) - (((NTN_) * 8) & 31)) * 8 + ((obid() >> 1) & 7)) * 2 + (obid() & 1))
#define TAIL_STRIDE(NTN_) ((32 - (((NTN_) * 8) & 31)) * 16)
__global__ void __launch_bounds__(512) mega(Params p) {
  __shared__ __attribute__((aligned(16))) char smem[131072];
  char* vsm = smem + (threadIdx.x >> 8) * 65536;
  cg::grid_group grid = cg::this_grid();

  __shared__ u32x4 xb_words;
  if (threadIdx.x == 0) { u32x4 z = {0u, 0u, 0u, 0u}; xb_words = z; }
  if (blockIdx.x == 0) for (int i = threadIdx.x; i < XCD_BAR_WORDS; i += 512) ((unsigned*)(WSB() + OFF_BAR))[i] = 0u;
  __syncthreads();
  mod_phase(PP()->c_ctx, PP()->c, PP()->w_mod, PP()->b_mod, MOD, vsm);
  rot_phase(ROTC, ROTS);
  CONVERT_MIXER(0, -1, 0);
  grid.sync();
  (void)xcd_barrier_post((unsigned*)(WSB() + OFF_BAR), (volatile LAS unsigned*)&xb_words);

  for (int l = 0; l < 4; ++l) {
    const int kind = l % 3, j = l / 3;
    const float* modl = MOD + (size_t)l * 5 * 6144;
    if (kind != 0) CONVERT_FFN(l, -1, 0);
    if (l == 0)
      row_phase(PP()->x_prompt, PP()->x_sample, nullptr, nullptr, nullptr, xo, H, PP()->norm_g + (l * 4 + 0) * 1024, modl + 0, modl + 1024);
    else
      row_phase(xo, xo + (size_t)TP * D, (const bf16_t*)RA, MOD + (size_t)(l - 1) * 5 * 6144 + 5120, PP()->norm_g + ((l - 1) * 4 + 3) * 1024,
                xo, H, PP()->norm_g + (l * 4 + 0) * 1024, modl + 0, modl + 1024);
    GSYNC();

    bf16_t* Mx = (bf16_t*)RB;
    if (kind == 0) {
      bf16_t* Z = (bf16_t*)RA;
      bf16_t* XBC = (bf16_t*)(RA + (size_t)T * 2048 * 2);
      bf16_t* S = XBC;
      bf16_t* XT = (bf16_t*)RB;
      bf16_t* Bm = (bf16_t*)(RB + (size_t)T * 2048 * 2);
      bf16_t* Cm = (bf16_t*)(RB + (size_t)T * 2048 * 2 + (size_t)T * 1024 * 2);
      {
        EpiSsdIn2 epi{Z, XT, Bm, Cm, (bf16_t*)(WSB() + OFF_UE), DT, PP()->ssd_dt_bias + j * 64,
                      PP()->ssd_conv_w + (size_t)j * 3 * 4096, PP()->ssd_conv_b + (size_t)j * 4096};
        gemm_phase(H, 1024, WA, 1024, 25, epi, smem);
      }
      if (gridDim.x == 256) { if (TAIL_IDLE(25)) CONVERT_FFN(l, TAIL_FIRST(25), TAIL_STRIDE(25)); }
      else CONVERT_FFN(l, -1, 0);
      GSYNC();
      ssd_fix_phase((const bf16_t*)(WSB() + OFF_UE), PP()->ssd_conv_w + (size_t)j * 3 * 4096, PP()->ssd_conv_b + (size_t)j * 4096, XT, Bm, Cm);
      ssd_cumsum_phase(DT, PP()->ssd_a_log + j * 64, ACST, BST, WST, DEC);
      GSYNC();
      ssd_states_phase(XT, Bm, WST, S, vsm);
      GSYNC();
      ssd_scan_phase(S, DEC, PP()->state_ssm, j, xo + OUT_STATE);
      GSYNC();
      ssd_y_phase(XT, Bm, Cm, S, ACST, BST, PP()->ssd_d + j * 32, Z, vsm);
      GSYNC();
      ssq_phase(Z, RSTD);
      GSYNC();
      {
        EpiBF16 epi{Mx, 1024, RSTD};
        gemm_phase(Z, 2048, WB, 2048, 4, epi, smem);
      }
      GSYNC();
    } else if (kind == 1) {
      bf16_t* BCU = (bf16_t*)RA;
      {
        EpiBF16 epi{BCU, 3072, nullptr};
        gemm_phase(H, 1024, WA, 1024, 12, epi, smem);
      }
      GSYNC();
      sc_mid_phase(BCU, PP()->sc_conv_w, H);
      GSYNC();
      {
        EpiBF16 epi{Mx, 1024, nullptr};
        gemm_phase(H, 1024, WB, 1024, 4, epi, smem);
      }
      GSYNC();
    } else {
      bf16_t* Q = (bf16_t*)RA;
      bf16_t* KB = (bf16_t*)(RA + (size_t)T * 1024 * 2);
      bf16_t* VT = (bf16_t*)(RA + (size_t)T * 1024 * 2 + (size_t)17408 * 1024 * 2);
      const float lam_init = 0.8f - 0.6f * __expf(-0.3f * (float)l);
      float d01 = 0.f, d23 = 0.f;
      for (int i = 0; i < 64; ++i) { d01 += PP()->da_lambda[i] * PP()->da_lambda[64 + i]; d23 += PP()->da_lambda[128 + i] * PP()->da_lambda[192 + i]; }
      const float lam = __expf(d01) - __expf(d23) + lam_init;
      cache_phase(PP()->cache_k, PP()->cache_v, KB, VT);
      {
        EpiQKV epi{Q, KB, VT, xo + OUT_CK, xo + OUT_CV, ROTC, ROTS};
        gemm_phase(H, 1024, WA, 1024, 12, epi, smem);
      }
      GSYNC();
      attn_phase(Q, KB, VT, H, PP()->da_subln_g, lam, lam_init, vsm);
      GSYNC();
      {
        EpiBF16 epi{Mx, 1024, nullptr};
        gemm_phase(H, 1024, WB, 1024, 4, epi, smem);
      }
      GSYNC();
    }
    row_phase(xo, xo + (size_t)TP * D, Mx, modl + 2048, PP()->norm_g + (l * 4 + 1) * 1024, xo, H, PP()->norm_g + (l * 4 + 2) * 1024, modl + 3072, modl + 4096);
    GSYNC();
    {
      EpiGate epi{(bf16_t*)RB, (bf16_t*)(WSB() + OFF_UE), PP()->ffn_conv_w + (size_t)l * 3 * 5632};
      gemm_phase(H, 1024, WU, 1024, 22, epi, smem);
    }
    if (l < 3) {
      if (gridDim.x == 256) { if (TAIL_IDLE(22)) CONVERT_MIXER(l + 1, TAIL_FIRST(22), TAIL_STRIDE(22)); }
      else CONVERT_MIXER(l + 1, -1, 0);
    }
    GSYNC();
    if (gridDim.x == 256) {
      const int bid_ = obid() >> 1;
      const int tm_ = (bid_ & 7) * 8 + ((bid_ >> 3) & 7);
      ffn_fix_phase((const bf16_t*)(WSB() + OFF_UE), PP()->ffn_conv_w + (size_t)l * 3 * 5632, (bf16_t*)RB, 2 * tm_, 2,
                    (obid() & 1) * 256 + otid(), 512);
      __syncthreads();
    } else {
      ffn_fix_phase((const bf16_t*)(WSB() + OFF_UE), PP()->ffn_conv_w + (size_t)l * 3 * 5632, (bf16_t*)RB);
      GSYNC();
    }
    {
      EpiBF16 epi{(bf16_t*)RA, 1024, nullptr};
      gemm_phase((const bf16_t*)RB, 2816, WD, 2816, 4, epi, smem);
    }
    GSYNC();
  }
  row_phase(xo, xo + (size_t)TP * D, (const bf16_t*)RA, MOD + (size_t)3 * 5 * 6144 + 5120, PP()->norm_g + (3 * 4 + 3) * 1024,
            xo, nullptr, nullptr, nullptr, nullptr);
}

#undef MOD
#undef ROTC
#undef ROTS
#undef RSTD
#undef DT
#undef ACST
#undef BST
#undef WST
#undef DEC
#undef WA
#undef WB
#undef WU
#undef WD
#undef H
#undef RA
#undef RB
#undef xo
extern "C" void kernel_launch(void* const* d_in, const int* in_sizes, int n_in, void* d_out, int out_size, void* d_ws, size_t ws_size,
                              hipStream_t stream) {
  if (ws_size < WS_NEED) { fprintf(stderr, "workspace too small: %zu < %zu\n", ws_size, (size_t)WS_NEED); return; }
  static int grid_blocks = 0;
  if (!grid_blocks) {
    int dev = 0, cus = 0, per_cu = 0;
    hipGetDevice(&dev);
    hipDeviceGetAttribute(&cus, hipDeviceAttributeMultiprocessorCount, dev);
    hipOccupancyMaxActiveBlocksPerMultiprocessor(&per_cu, mega, 512, 0);
    if (per_cu > 1) per_cu = 1;
    grid_blocks = cus * per_cu;
  }
  Params p{};
  const float** pp = (const float**)&p;
  for (int i = 0; i < 28; ++i) pp[i] = (const float*)d_in[i];
  p.out = (float*)d_out;
  p.ws = (char*)d_ws;
  void* args[] = {&p};
  hipError_t e = hipLaunchCooperativeKernel((void*)mega, dim3(grid_blocks), dim3(512), args, 0, stream);
  if (e != hipSuccess) fprintf(stderr, "cooperative launch failed: %s (grid %d)\n", hipGetErrorString(e), grid_blocks);
}
```

```cpp
#include <hip/hip_runtime.h>
#include <hip/hip_cooperative_groups.h>
#include <cstdio>
namespace cg = cooperative_groups;

#define DI __device__ __forceinline__
typedef unsigned short bf16_t;
using bf16x8 = __attribute__((ext_vector_type(8))) short;
using f32x16 = __attribute__((ext_vector_type(16))) float;
typedef __bf16 bf2_t __attribute__((ext_vector_type(2)));
typedef float f2_t __attribute__((ext_vector_type(2)));
typedef unsigned u32x4 __attribute__((ext_vector_type(4)));
typedef unsigned u32x2 __attribute__((ext_vector_type(2)));
typedef float f32x4 __attribute__((ext_vector_type(4)));
#define MFMA(a, b, c) __builtin_amdgcn_mfma_f32_32x32x16_bf16((a), (b), (c), 0, 0, 0)

constexpr int T = 16384, TP = 8192, D = 1024;
constexpr float EPS = 1e-6f;

constexpr size_t al256(size_t x) { return (x + 255) & ~(size_t)255; }
constexpr size_t OFF_MOD = 0;
constexpr size_t OFF_ROT = al256(OFF_MOD + (size_t)4 * 5 * 6144 * 4);
constexpr size_t OFF_RSTD = al256(OFF_ROT + (size_t)2 * 2048 * 32 * 4);
constexpr size_t OFF_DT = al256(OFF_RSTD + (size_t)T * 4);
constexpr size_t OFF_ACST = al256(OFF_DT + (size_t)T * 64 * 4);
constexpr size_t OFF_BST = al256(OFF_ACST + (size_t)128 * 64 * 128 * 4);
constexpr size_t OFF_WST = al256(OFF_BST + (size_t)128 * 64 * 128 * 4);
constexpr size_t OFF_DEC = al256(OFF_WST + (size_t)128 * 64 * 128 * 4);
constexpr size_t OFF_WA = al256(OFF_DEC + (size_t)128 * 64 * 4);
constexpr size_t OFF_WB = al256(OFF_WA + (size_t)6400 * 1024 * 2);
constexpr size_t OFF_WU = al256(OFF_WB + (size_t)1024 * 2048 * 2);
constexpr size_t OFF_WD = al256(OFF_WU + (size_t)5632 * 1024 * 2);
constexpr size_t OFF_H = al256(OFF_WD + (size_t)1024 * 2816 * 2);
constexpr size_t OFF_RA = al256(OFF_H + (size_t)T * 1024 * 2);
constexpr size_t OFF_RB = al256(OFF_RA + (size_t)201326592);
constexpr size_t OFF_BAR = al256(OFF_RB + (size_t)134217728);
constexpr size_t OFF_UE = al256(OFF_BAR + (size_t)3456 * 4);
constexpr size_t WS_NEED = OFF_UE + (size_t)128 * 4 * 5632 * 2;

constexpr size_t OUT_STATE = (size_t)2 * TP * D;
constexpr size_t OUT_CK = OUT_STATE + (size_t)33554432;
constexpr size_t OUT_CV = OUT_CK + (size_t)8388608;

struct Params {
  const float *x_prompt, *x_sample, *state_ssm, *cache_k, *cache_v, *c, *c_ctx, *w_mod, *b_mod, *norm_g;
  const float *ssd_w_in, *ssd_conv_w, *ssd_conv_b, *ssd_dt_bias, *ssd_a_log, *ssd_d, *ssd_norm_g, *ssd_w_out;
  const float *sc_w_in, *sc_conv_w, *sc_w_out, *da_w_qkv, *da_lambda, *da_subln_g, *da_w_out;
  const float *ffn_w_up, *ffn_conv_w, *ffn_w_down;
  float* out;
  char* ws;
};

DI float bf2f(bf16_t v) { return __uint_as_float(((unsigned)v) << 16); }
DI unsigned pk2(float a, float b) { f2_t v = {a, b}; bf2_t r = __builtin_convertvector(v, bf2_t); return __builtin_bit_cast(unsigned, r); }
DI bf16_t f2bf(float a) { return (bf16_t)(pk2(a, 0.f) & 0xffffu); }
DI float lo_f(unsigned u) { return __uint_as_float(u << 16); }
DI float hi_f(unsigned u) { return __uint_as_float(u & 0xffff0000u); }
DI bf16x8 ld8(const bf16_t* p) { return *(const bf16x8*)p; }
DI bf16x8 ld4x2(const bf16_t* p0, const bf16_t* p1) {
  u32x2 a = *(const u32x2*)p0, b = *(const u32x2*)p1;
  u32x4 v = {a.x, a.y, b.x, b.y};
  return __builtin_bit_cast(bf16x8, v);
}
DI bf16x8 pack8(float a0, float a1, float a2, float a3, float a4, float a5, float a6, float a7) {
  u32x4 v = {pk2(a0, a1), pk2(a2, a3), pk2(a4, a5), pk2(a6, a7)};
  return __builtin_bit_cast(bf16x8, v);
}
DI float shx(float v, int mask) {
  int lane = __builtin_amdgcn_mbcnt_hi(-1, __builtin_amdgcn_mbcnt_lo(-1, 0));
  asm volatile("" : "+v"(lane));
  return __builtin_bit_cast(float, __builtin_amdgcn_ds_bpermute((lane ^ mask) << 2, __builtin_bit_cast(int, v)));
}
DI float wave_sum(float v) {
#pragma unroll
  for (int o = 32; o > 0; o >>= 1) v += shx(v, o);
  return v;
}
DI float silu(float x) { return x / (1.f + __expf(-x)); }
DI void zero16(f32x16& a) {
#pragma unroll
  for (int i = 0; i < 16; ++i) a[i] = 0.f;
}
DI int crow(int i, int half) { return (i & 3) + 8 * (i >> 2) + 4 * half; }
DI int otid() { int t = threadIdx.x & 255; asm volatile("" : "+v"(t)); return t; }
DI int obid() { int b = blockIdx.x * 2 + (threadIdx.x >> 8); asm volatile("" : "+v"(b)); return __builtin_amdgcn_readfirstlane(b); }
#define VGRID (gridDim.x * 2)

DI void mod_phase(const float* c_ctx, const float* c_in, const float* w_mod, const float* b_mod, float* MOD, char* smem) {
  float* s = (float*)smem;
  float* red = s + 5 * 1024;
  const int tid = otid();
  for (int it = obid(); it < 4 * 96; it += VGRID) {
    const int l = it / 96, n0 = (it % 96) * 64;
    __syncthreads();
    for (int i = tid; i < 5 * 1024; i += 256) {
      const int c = i >> 10, k = i & 1023;
      const float v = (c == 0) ? c_ctx[k] : c_in[(c - 1) * 1024 + k];
      s[i] = silu(v);
    }
    __syncthreads();
    const int cg = tid & 15, kg = tid >> 4;
    const float* w = w_mod + ((size_t)l * 1024 + kg * 64) * 6144 + n0 + 4 * cg;
    f32x4 a0 = {0.f, 0.f, 0.f, 0.f}, a1 = a0, a2 = a0, a3 = a0, a4 = a0;
#pragma unroll 8
    for (int k = 0; k < 64; ++k) {
      const f32x4 wv = __builtin_nontemporal_load((const f32x4*)(w + (size_t)k * 6144));
      const int kk = kg * 64 + k;
      a0 += s[kk] * wv; a1 += s[1024 + kk] * wv; a2 += s[2048 + kk] * wv; a3 += s[3072 + kk] * wv; a4 += s[4096 + kk] * wv;
    }
    *(f32x4*)(red + (kg * 5 + 0) * 64 + 4 * cg) = a0; *(f32x4*)(red + (kg * 5 + 1) * 64 + 4 * cg) = a1;
    *(f32x4*)(red + (kg * 5 + 2) * 64 + 4 * cg) = a2; *(f32x4*)(red + (kg * 5 + 3) * 64 + 4 * cg) = a3;
    *(f32x4*)(red + (kg * 5 + 4) * 64 + 4 * cg) = a4;
    __syncthreads();
    for (int i = tid; i < 320; i += 256) {
      const int c = i >> 6, cc = i & 63;
      float v = b_mod[l * 6144 + n0 + cc];
#pragma unroll
      for (int g = 0; g < 16; ++g) v += red[(g * 5 + c) * 64 + cc];
      MOD[(size_t)(l * 5 + c) * 6144 + n0 + cc] = v;
    }
  }
}

DI void rot_phase(float* ROTC, float* ROTS) {
  for (int i = obid() * 256 + otid(); i < 2048 * 32; i += VGRID * 256) {
    const int pos = i >> 5, k = i & 31;
    const float inv = powf(10000.f, -(float)(k & 15) / 16.f);
    const float base = (k < 16) ? (float)(pos >> 6) : (float)(pos & 63);
    const float ang = base * inv;
    ROTC[i] = cosf(ang);
    ROTS[i] = sinf(ang);
  }
}

DI int ffn_perm_row(int n) { return n < 2816 ? ((n >> 5) * 64 + (n & 31)) : (((n - 2816) >> 5) * 64 + 32 + ((n - 2816) & 31)); }
DI void convert_wt(const float* __restrict__ src, int K, int N, bf16_t* __restrict__ dst, const float* __restrict__ kscale, char* smem, bool perm = false, int first = -1, int stride = 0) {
  float* tile = (float*)smem;
  const int tid = otid();
  const int tk = K >> 6, tn = N >> 6;
  if (first < 0) { first = obid(); stride = VGRID; }
  for (int it = first; it < tk * tn; it += stride) {
    const int k0 = (it % tk) << 6, n0 = (it / tk) << 6;
    __syncthreads();
#pragma unroll
    for (int ps = 0; ps < 4; ++ps) {
      const int k = (tid >> 4) + 16 * ps, n4 = (tid & 15) * 4;
      const f32x4 v = __builtin_nontemporal_load((const f32x4*)(src + (size_t)(k0 + k) * N + n0 + n4));
      const float sc = kscale ? kscale[k0 + k] : 1.f;
      tile[k * 65 + n4 + 0] = v.x * sc; tile[k * 65 + n4 + 1] = v.y * sc;
      tile[k * 65 + n4 + 2] = v.z * sc; tile[k * 65 + n4 + 3] = v.w * sc;
    }
    __syncthreads();
    const int n = tid >> 2, ks = (tid & 3) * 16;
    unsigned q[8];
#pragma unroll
    for (int j = 0; j < 8; ++j) q[j] = pk2(tile[(ks + 2 * j) * 65 + n], tile[(ks + 2 * j + 1) * 65 + n]);
    const int nrow = perm ? ffn_perm_row(n0 + n) : n0 + n;
    u32x4* d = (u32x4*)(dst + (size_t)nrow * K + k0 + ks);
    u32x4 v0 = {q[0], q[1], q[2], q[3]}, v1 = {q[4], q[5], q[6], q[7]};
    d[0] = v0; d[1] = v1;
  }
}

DI void row_phase(const float* __restrict__ xin_p, const float* __restrict__ xin_s, const bf16_t* __restrict__ f, const float* __restrict__ gate,
                  const float* __restrict__ gprev, float* xout, bf16_t* __restrict__ hout, const float* __restrict__ gn,
                  const float* __restrict__ sh, const float* __restrict__ sc) {
  const int lane = otid() & 63;
  const int wid = obid() * 4 + (otid() >> 6), nw = VGRID * 4;
  for (int t0 = wid * 2; t0 < T; t0 += nw * 2) {
    const int mrow = t0 < TP ? 0 : 1 + ((t0 - TP) >> 11);
    const float* xr = (t0 < TP) ? xin_p + (size_t)t0 * D : xin_s + (size_t)(t0 - TP) * D;
    f32x4 xv[2][4], fv[2][4], gt[4], gp[4], g[4], s1[4], s0[4];
#pragma unroll
    for (int r = 0; r < 2; ++r)
#pragma unroll
      for (int j = 0; j < 4; ++j) xv[r][j] = *(const f32x4*)(xr + (size_t)r * D + lane * 4 + 256 * j);
    if (f) {
#pragma unroll
      for (int r = 0; r < 2; ++r)
#pragma unroll
        for (int j = 0; j < 4; ++j) {
          const u32x2 fr = *(const u32x2*)(f + (size_t)(t0 + r) * D + lane * 4 + 256 * j);
          f32x4 fx = {lo_f(fr.x), hi_f(fr.x), lo_f(fr.y), hi_f(fr.y)};
          fv[r][j] = fx;
        }
#pragma unroll
      for (int j = 0; j < 4; ++j) {
        gt[j] = *(const f32x4*)(gate + (size_t)mrow * 6144 + lane * 4 + 256 * j);
        gp[j] = *(const f32x4*)(gprev + lane * 4 + 256 * j);
      }
    }
    if (hout) {
#pragma unroll
      for (int j = 0; j < 4; ++j) {
        g[j] = *(const f32x4*)(gn + lane * 4 + 256 * j);
        s1[j] = *(const f32x4*)(sc + (size_t)mrow * 6144 + lane * 4 + 256 * j);
        s0[j] = *(const f32x4*)(sh + (size_t)mrow * 6144 + lane * 4 + 256 * j);
      }
    }
    if (f) {
      float q0 = 0.f, q1 = 0.f;
#pragma unroll
      for (int j = 0; j < 4; ++j) {
        q0 += fv[0][j].x * fv[0][j].x + fv[0][j].y * fv[0][j].y + fv[0][j].z * fv[0][j].z + fv[0][j].w * fv[0][j].w;
        q1 += fv[1][j].x * fv[1][j].x + fv[1][j].y * fv[1][j].y + fv[1][j].z * fv[1][j].z + fv[1][j].w * fv[1][j].w;
      }
      q0 = wave_sum(q0); q1 = wave_sum(q1);
      const float r0 = rsqrtf(q0 * (1.f / 1024.f) + EPS), r1 = rsqrtf(q1 * (1.f / 1024.f) + EPS);
#pragma unroll
      for (int j = 0; j < 4; ++j) {
        xv[0][j] += gt[j] * (fv[0][j] * r0 * gp[j]);
        xv[1][j] += gt[j] * (fv[1][j] * r1 * gp[j]);
      }
    }
#pragma unroll
    for (int r = 0; r < 2; ++r)
#pragma unroll
      for (int j = 0; j < 4; ++j) *(f32x4*)(xout + (size_t)(t0 + r) * D + lane * 4 + 256 * j) = xv[r][j];
    if (hout) {
      float q0 = 0.f, q1 = 0.f;
#pragma unroll
      for (int j = 0; j < 4; ++j) {
        q0 += xv[0][j].x * xv[0][j].x + xv[0][j].y * xv[0][j].y + xv[0][j].z * xv[0][j].z + xv[0][j].w * xv[0][j].w;
        q1 += xv[1][j].x * xv[1][j].x + xv[1][j].y * xv[1][j].y + xv[1][j].z * xv[1][j].z + xv[1][j].w * xv[1][j].w;
      }
      q0 = wave_sum(q0); q1 = wave_sum(q1);
      const float rr[2] = {rsqrtf(q0 * (1.f / 1024.f) + EPS), rsqrtf(q1 * (1.f / 1024.f) + EPS)};
#pragma unroll
      for (int r = 0; r < 2; ++r)
#pragma unroll
        for (int j = 0; j < 4; ++j) {
          const f32x4 hv = xv[r][j] * rr[r] * g[j] * (1.f + s1[j]) + s0[j];
          u32x2 o = {pk2(hv.x, hv.y), pk2(hv.z, hv.w)};
          *(u32x2*)(hout + (size_t)(t0 + r) * D + lane * 4 + 256 * j) = o;
        }
    }
  }
}

constexpr int GM = 4;
#define LAS3 __attribute__((address_space(3)))
constexpr int GSTG = 32768;
DI void glds16(const void* gsrc, unsigned lds_dst_uniform) {
  asm volatile("s_mov_b32 m0, %1\n\ts_nop 0\n\tglobal_load_lds_dwordx4 %0, off"
               : : "v"(gsrc), "s"(lds_dst_uniform) : "memory", "m0");
}
template <class Epi>
DI void gemm_phase(const bf16_t* __restrict__ A, int lda, const bf16_t* __restrict__ Bt, int K, int ntn, const Epi& epi, char* smem) {
  int tid = threadIdx.x;
  asm volatile("" : "+v"(tid));
  const int lane = tid & 63, wave = tid >> 6;
  const int wm = (wave >> 2) * 128, wn = (wave & 3) * 64;
  const int l31 = lane & 31, half = lane >> 5;
  const int grow = tid >> 2;
  const int gch = ((tid & 3) ^ ((tid >> 4) & 3)) * 8;
  const int sw = (l31 >> 2) & 3;
  LAS3 char* sm3 = (LAS3 char*)smem;
  const unsigned sbase = (unsigned)(size_t)smem;
  const int offA0 = (wm + l31) * 64 + ((half ^ sw) * 16);
  const int offA1 = (wm + l31) * 64 + (((2 + half) ^ sw) * 16);
  const int offB0 = 16384 + (wn + l31) * 64 + ((half ^ sw) * 16);
  const int offB1 = 16384 + (wn + l31) * 64 + (((2 + half) ^ sw) * 16);
  const int nk = K >> 5;
  int bid = blockIdx.x;
  asm volatile("" : "+v"(bid));
  bid = __builtin_amdgcn_readfirstlane(bid);
  const int xcd = bid & 7, gpx = gridDim.x >> 3;
  for (int idx = bid >> 3; idx < ntn * 8; idx += gpx) {
    const int tm = xcd * 8 + (idx & 7), tn = idx >> 3;
    const bf16_t* Ag = A + (size_t)(tm * 256 + grow) * lda + gch;
    const bf16_t* Bg = Bt + (size_t)(tn * 256 + grow) * K + gch;
    f32x16 acc[GM][2];
#pragma unroll
    for (int i = 0; i < GM; ++i)
#pragma unroll
      for (int j = 0; j < 2; ++j) zero16(acc[i][j]);
#define GISSUE(kt_, stg_)                                                                                         \
    do {                                                                                                          \
      const unsigned d_ = __builtin_amdgcn_readfirstlane(sbase + (stg_) * GSTG + wave * 1024);                    \
      glds16(Ag + (kt_) * 32, d_);                                                                                \
      glds16(Ag + (size_t)128 * lda + (kt_) * 32, d_ + 8192);                                                     \
      glds16(Bg + (kt_) * 32, d_ + 16384);                                                                        \
      glds16(Bg + (size_t)128 * K + (kt_) * 32, d_ + 16384 + 8192);                                               \
    } while (0)
    asm volatile("s_waitcnt vmcnt(0) lgkmcnt(0)" ::: "memory");
    __builtin_amdgcn_s_barrier();
    asm volatile("" ::: "memory");
    GISSUE(0, 0);
    GISSUE(1, 1);
    GISSUE(2, 2);
    bf16x8 pb[2], pa[GM];
    {
      const bf16x8 z8 = {0, 0, 0, 0, 0, 0, 0, 0};
      pb[0] = z8; pb[1] = z8;
#pragma unroll
      for (int mt = 0; mt < GM; ++mt) pa[mt] = z8;
    }
    for (int kt = 0; kt < nk; ++kt) {
      if (kt + 2 < nk) asm volatile("s_waitcnt vmcnt(8) lgkmcnt(0)" ::: "memory");
      else if (kt + 1 < nk) asm volatile("s_waitcnt vmcnt(4) lgkmcnt(0)" ::: "memory");
      else asm volatile("s_waitcnt vmcnt(0) lgkmcnt(0)" ::: "memory");
      __builtin_amdgcn_s_barrier();
      asm volatile("" ::: "memory");
      const int stg = kt & 3, stg3 = (kt + 3) & 3;
      const bool pre = kt + 3 < nk;
      const unsigned gd = __builtin_amdgcn_readfirstlane(sbase + stg3 * GSTG + wave * 1024);
      const bf16_t* Agk = Ag + (kt + 3) * 32;
      const bf16_t* Bgk = Bg + (kt + 3) * 32;
      const LAS3 char* st = sm3 + stg * GSTG;
      bf16x8 fb0[2], fa0[GM];
      fb0[0] = *(const LAS3 bf16x8*)(st + offB0);
      fb0[1] = *(const LAS3 bf16x8*)(st + offB0 + 32 * 64);
#pragma unroll
      for (int mt = 0; mt < GM; ++mt) fa0[mt] = *(const LAS3 bf16x8*)(st + offA0 + mt * 32 * 64);
      if (pre) glds16(Agk, gd);
      __builtin_amdgcn_sched_barrier(0);
#pragma unroll
      for (int mt = 0; mt < GM; ++mt) {
        acc[mt][0] = MFMA(pa[mt], pb[0], acc[mt][0]);
        acc[mt][1] = MFMA(pa[mt], pb[1], acc[mt][1]);
        if (mt == 1) { if (pre) glds16(Agk + (size_t)128 * lda, gd + 8192); __builtin_amdgcn_sched_barrier(0); }
      }
      __builtin_amdgcn_sched_barrier(0);
      pb[0] = *(const LAS3 bf16x8*)(st + offB1);
      pb[1] = *(const LAS3 bf16x8*)(st + offB1 + 32 * 64);
#pragma unroll
      for (int mt = 0; mt < GM; ++mt) pa[mt] = *(const LAS3 bf16x8*)(st + offA1 + mt * 32 * 64);
      __builtin_amdgcn_sched_barrier(0);
#pragma unroll
      for (int mt = 0; mt < GM; ++mt) {
        acc[mt][0] = MFMA(fa0[mt], fb0[0], acc[mt][0]);
        acc[mt][1] = MFMA(fa0[mt], fb0[1], acc[mt][1]);
        if (mt == 0) { if (pre) glds16(Bgk, gd + 16384); __builtin_amdgcn_sched_barrier(0); }
        if (mt == 2) { if (pre) glds16(Bgk + (size_t)128 * K, gd + 16384 + 8192); __builtin_amdgcn_sched_barrier(0); }
      }
    }
#pragma unroll
    for (int mt = 0; mt < GM; ++mt) {
      acc[mt][0] = MFMA(pa[mt], pb[0], acc[mt][0]);
      acc[mt][1] = MFMA(pa[mt], pb[1], acc[mt][1]);
    }
#undef GISSUE
    epi(acc, tm * 256 + wm, tn * 256 + wn, lane);
  }
  asm volatile("s_waitcnt vmcnt(0) lgkmcnt(0)" ::: "memory");
  __syncthreads();
}

struct EpiF32 {
  float* out; int ld; const float* rstd;
  DI void operator()(const f32x16 (&acc)[GM][2], int rbase, int cbase, int lane) const {
    const int l31 = lane & 31, half = lane >> 5;
#pragma unroll
    for (int mt = 0; mt < GM; ++mt)
#pragma unroll
      for (int i = 0; i < 16; ++i) {
        const int row = rbase + 32 * mt + crow(i, half);
        const float s = rstd ? rstd[row] : 1.f;
#pragma unroll
        for (int nt = 0; nt < 2; ++nt) out[(size_t)row * ld + cbase + 32 * nt + l31] = acc[mt][nt][i] * s;
      }
  }
};
struct EpiBF16 {
  bf16_t* out; int ld; const float* rstd;
  DI void operator()(const f32x16 (&acc)[GM][2], int rbase, int cbase, int lane) const {
    const int l31 = lane & 31, half = lane >> 5;
#pragma unroll
    for (int mt = 0; mt < GM; ++mt)
#pragma unroll
      for (int i = 0; i < 16; ++i) {
        const int row = rbase + 32 * mt + crow(i, half);
        const float s = rstd ? rstd[row] : 1.f;
#pragma unroll
        for (int nt = 0; nt < 2; ++nt) out[(size_t)row * ld + cbase + 32 * nt + l31] = f2bf(acc[mt][nt][i] * s);
      }
  }
};
struct EpiSsdIn {
  bf16_t* Z; bf16_t* XBC; float* DT; const float* dt_bias;
  DI void operator()(const f32x16 (&acc)[GM][2], int rbase, int cbase, int lane) const {
    const int l31 = lane & 31, half = lane >> 5;
    if (cbase >= 6208) return;
#pragma unroll
    for (int mt = 0; mt < GM; ++mt)
#pragma unroll
      for (int i = 0; i < 16; ++i) {
        const int row = rbase + 32 * mt + crow(i, half);
#pragma unroll
        for (int nt = 0; nt < 2; ++nt) {
          const int col = cbase + 32 * nt + l31;
          const float v = acc[mt][nt][i];
          if (cbase < 2048) Z[(size_t)row * 2048 + col] = f2bf(v);
          else if (cbase < 6144) XBC[(size_t)row * 4096 + col - 2048] = f2bf(v);
          else {
            const float x = v + dt_bias[col - 6144];
            const float u = __expf(-fabsf(x));
            const float lp = (u < 0.01f) ? u * (1.f - u * (0.5f - u * (1.f / 3.f))) : __logf(1.f + u);
            DT[(size_t)row * 64 + col - 6144] = fmaxf(x, 0.f) + lp;
          }
        }
      }
  }
};
struct EpiQKV {
  bf16_t* Q; bf16_t* KB; bf16_t* VT; float* out_k; float* out_v; const float* ROTC; const float* ROTS;
  DI void operator()(const f32x16 (&acc)[GM][2], int rbase, int cbase, int lane) const {
    const int l31 = lane & 31, half = lane >> 5;
    const bool sample = rbase >= TP;
    if (cbase < 2048) {
      const bool isq = cbase < 1024;
#pragma unroll
      for (int mt = 0; mt < GM; ++mt)
#pragma unroll
        for (int i = 0; i < 16; ++i) {
          const int t = rbase + 32 * mt + crow(i, half);
          float x1 = acc[mt][0][i], x2 = acc[mt][1][i];
          int krow_ = t;
          if (sample) {
            const int pos = (t - TP) & 2047, b = (t - TP) >> 11;
            const float c = ROTC[pos * 32 + l31], s = ROTS[pos * 32 + l31];
            const float o1 = x1 * c - x2 * s, o2 = x2 * c + x1 * s;
            x1 = o1; x2 = o2;
            krow_ = TP + b * 2304 + 256 + pos;
          }
          if (isq) {
            Q[(size_t)t * 1024 + cbase + l31] = f2bf(x1 * 0.125f);
            Q[(size_t)t * 1024 + cbase + 32 + l31] = f2bf(x2 * 0.125f);
          } else {
            const int c0 = cbase - 1024;
            KB[(size_t)krow_ * 1024 + c0 + l31] = f2bf(x1);
            KB[(size_t)krow_ * 1024 + c0 + 32 + l31] = f2bf(x2);
            if (!sample) {
              __builtin_nontemporal_store(x1, out_k + (size_t)t * 1024 + c0 + l31);
              __builtin_nontemporal_store(x2, out_k + (size_t)t * 1024 + c0 + 32 + l31);
            }
          }
        }
    } else {
      const int c0 = cbase - 2048;
#pragma unroll
      for (int mt = 0; mt < GM; ++mt)
#pragma unroll
        for (int qd = 0; qd < 4; ++qd) {
          const int t = rbase + 32 * mt + 8 * qd + 4 * half;
          size_t vb; int L, key;
          if (sample) { const int b = (t - TP) >> 11; vb = (size_t)TP * 1024 + (size_t)b * 1024 * 2304; L = 2304; key = 256 + ((t - TP) & 2047); }
          else { const int s = t >> 8; vb = (size_t)s * 1024 * 256; L = 256; key = t & 255; }
#pragma unroll
          for (int nt = 0; nt < 2; ++nt) {
            const int c = c0 + 32 * nt + l31;
            const float v0 = acc[mt][nt][4 * qd + 0], v1 = acc[mt][nt][4 * qd + 1], v2 = acc[mt][nt][4 * qd + 2], v3 = acc[mt][nt][4 * qd + 3];
            u32x2 o = {pk2(v0, v1), pk2(v2, v3)};
            *(u32x2*)(VT + vb + (size_t)c * L + key) = o;
            if (!sample) {
              __builtin_nontemporal_store(v0, out_v + (size_t)(t + 0) * 1024 + c); __builtin_nontemporal_store(v1, out_v + (size_t)(t + 1) * 1024 + c);
              __builtin_nontemporal_store(v2, out_v + (size_t)(t + 2) * 1024 + c); __builtin_nontemporal_store(v3, out_v + (size_t)(t + 3) * 1024 + c);
            }
          }
        }
    }
  }
};

struct EpiGate {
  bf16_t* G; bf16_t* UE; const float* cw;
  DI void operator()(const f32x16 (&acc)[GM][2], int rbase, int cbase, int lane) const {
    const int l31 = lane & 31, half = lane >> 5;
    const int ch = (cbase >> 6) * 32 + l31;
    const float w0g = cw[ch], w1g = cw[5632 + ch], w2g = cw[11264 + ch];
    const float w0v = cw[2816 + ch], w1v = cw[5632 + 2816 + ch], w2v = cw[11264 + 2816 + ch];
    const int wt = rbase >> 7;
    {
      bf16_t* ue = UE + (size_t)wt * 4 * 5632 + cbase + l31;
      if (half == 0) {
        ue[0] = f2bf(acc[0][0][0]); ue[32] = f2bf(acc[0][1][0]);
        ue[5632] = f2bf(acc[0][0][1]); ue[5632 + 32] = f2bf(acc[0][1][1]);
      } else {
        ue[2 * 5632] = f2bf(acc[3][0][14]); ue[2 * 5632 + 32] = f2bf(acc[3][1][14]);
        ue[3 * 5632] = f2bf(acc[3][0][15]); ue[3 * 5632 + 32] = f2bf(acc[3][1][15]);
      }
    }
    bf16_t* gp = G + (size_t)(rbase + 4 * half) * 2816 + ch;
    float g3prev = 0.f, v3prev = 0.f, g0cur = shx(acc[0][0][0], 32), v0cur = shx(acc[0][1][0], 32);
#pragma unroll
    for (int mq = 0; mq < 16; ++mq) {
      const int mt = mq >> 2, q = mq & 3;
      const float g3cur = shx(acc[mt][0][4 * q + 3], 32), v3cur = shx(acc[mt][1][4 * q + 3], 32);
      const float g0next = (mq < 15) ? shx(acc[(mq + 1) >> 2][0][4 * ((mq + 1) & 3)], 32) : 0.f;
      const float v0next = (mq < 15) ? shx(acc[(mq + 1) >> 2][1][4 * ((mq + 1) & 3)], 32) : 0.f;
#pragma unroll
      for (int e = 0; e < 4; ++e) {
        float pg, pv, ng, nv;
        if (e > 0) { pg = acc[mt][0][4 * q + e - 1]; pv = acc[mt][1][4 * q + e - 1]; }
        else { pg = half ? g3cur : g3prev; pv = half ? v3cur : v3prev; }
        if (e < 3) { ng = acc[mt][0][4 * q + e + 1]; nv = acc[mt][1][4 * q + e + 1]; }
        else { ng = half ? g0next : g0cur; nv = half ? v0next : v0cur; }
        const float gg = w0g * pg + w1g * acc[mt][0][4 * q + e] + w2g * ng;
        const float vv = w0v * pv + w1v * acc[mt][1][4 * q + e] + w2v * nv;
        gp[(size_t)(32 * mt + 8 * q + e) * 2816] = f2bf(silu(gg) * vv);
      }
      g3prev = g3cur; v3prev = v3cur; g0cur = g0next; v0cur = v0next;
    }
  }
};

struct EpiSsdIn2 {
  bf16_t* Z; bf16_t* XT; bf16_t* Bm; bf16_t* Cm; bf16_t* UE; float* DT; const float* dt_bias; const float* cw; const float* cb;
  DI void operator()(const f32x16 (&acc)[GM][2], int rbase, int cbase, int lane) const {
    const int l31 = lane & 31, half = lane >> 5;
    if (cbase >= 6208) return;
    if (cbase < 2048) {
#pragma unroll
      for (int mt = 0; mt < GM; ++mt)
#pragma unroll
        for (int i = 0; i < 16; ++i) {
          const int row = rbase + 32 * mt + crow(i, half);
#pragma unroll
          for (int nt = 0; nt < 2; ++nt) Z[(size_t)row * 2048 + cbase + 32 * nt + l31] = f2bf(acc[mt][nt][i]);
        }
      return;
    }
    if (cbase >= 6144) {
#pragma unroll
      for (int mt = 0; mt < GM; ++mt)
#pragma unroll
        for (int i = 0; i < 16; ++i) {
          const int row = rbase + 32 * mt + crow(i, half);
#pragma unroll
          for (int nt = 0; nt < 2; ++nt) {
            const int col = cbase + 32 * nt + l31;
            const float x = acc[mt][nt][i] + dt_bias[col - 6144];
            const float u = __expf(-fabsf(x));
            const float lp = (u < 0.01f) ? u * (1.f - u * (0.5f - u * (1.f / 3.f))) : __logf(1.f + u);
            DT[(size_t)row * 64 + col - 6144] = fmaxf(x, 0.f) + lp;
          }
        }
      return;
    }
    const int chunk = rbase >> 7;
#pragma unroll
    for (int nt = 0; nt < 2; ++nt) {
      const int cc = cbase - 2048 + 32 * nt + l31;
      const float w0 = cw[cc], w1 = cw[4096 + cc], w2 = cw[8192 + cc], bb = cb[cc];
      {
        bf16_t* ue = UE + (size_t)chunk * 4 * 4096 + cc;
        if (half == 0) { ue[0] = f2bf(acc[0][nt][0]); ue[4096] = f2bf(acc[0][nt][1]); }
        else { ue[2 * 4096] = f2bf(acc[3][nt][14]); ue[3 * 4096] = f2bf(acc[3][nt][15]); }
      }
      float r3prev = 0.f, r0cur = shx(acc[0][nt][0], 32);
#pragma unroll
      for (int mq = 0; mq < 16; ++mq) {
        const int mt = mq >> 2, q = mq & 3;
        const float r3cur = shx(acc[mt][nt][4 * q + 3], 32);
        const float r0next = (mq < 15) ? shx(acc[(mq + 1) >> 2][nt][4 * ((mq + 1) & 3)], 32) : 0.f;
        float o[4];
#pragma unroll
        for (int e = 0; e < 4; ++e) {
          float pv, nv;
          if (e > 0) pv = acc[mt][nt][4 * q + e - 1];
          else pv = half ? r3cur : r3prev;
          if (e < 3) nv = acc[mt][nt][4 * q + e + 1];
          else nv = half ? r0next : r0cur;
          o[e] = silu(bb + w0 * pv + w1 * acc[mt][nt][4 * q + e] + w2 * nv);
        }
        r3prev = r3cur; r0cur = r0next;
        const int R0 = 32 * mt + 8 * q + 4 * half;
        if (cbase < 4096) {
          u32x2 v = {pk2(o[0], o[1]), pk2(o[2], o[3])};
          *(u32x2*)(XT + ((size_t)chunk * 2048 + cc) * 128 + R0) = v;
        } else {
          bf16_t* dst = (cbase < 5120) ? (Bm + (size_t)(rbase + R0) * 1024 + cc - 2048) : (Cm + (size_t)(rbase + R0) * 1024 + cc - 3072);
          dst[0] = f2bf(o[0]); dst[1024] = f2bf(o[1]); dst[2048] = f2bf(o[2]); dst[3072] = f2bf(o[3]);
        }
      }
    }
  }
};

DI bool has_prev(int t) { return t < TP ? (t & 255) != 0 : ((t - TP) & 2047) != 0; }
DI bool has_next(int t) { return t < TP ? (t & 255) != 255 : ((t - TP) & 2047) != 2047; }

DI void unpack8(const u32x4& v, float* o) {
  o[0] = lo_f(v.x); o[1] = hi_f(v.x); o[2] = lo_f(v.y); o[3] = hi_f(v.y);
  o[4] = lo_f(v.z); o[5] = hi_f(v.z); o[6] = lo_f(v.w); o[7] = hi_f(v.w);
}

DI void ssd_conv_phase(const bf16_t* __restrict__ XBC, const float* __restrict__ cw, const float* __restrict__ cb,
                       bf16_t* __restrict__ XT, bf16_t* __restrict__ Bm, bf16_t* __restrict__ Cm) {
  const int tid = otid();
  for (int it = obid(); it < 128 * 32; it += VGRID) {
    const int chunk = it >> 5, c = ((it & 31) << 6) + (tid & 63), sg = tid >> 6;
    const int t0 = chunk * 128 + sg * 32;
    const float w0 = cw[c], w1 = cw[4096 + c], w2 = cw[8192 + c], bb = cb[c];
    float prev = has_prev(t0) ? bf2f(XBC[(size_t)(t0 - 1) * 4096 + c]) : 0.f;
    float cur = bf2f(XBC[(size_t)t0 * 4096 + c]);
#pragma unroll
    for (int s8 = 0; s8 < 4; ++s8) {
      float o[8];
#pragma unroll
      for (int j = 0; j < 8; ++j) {
        const int t = t0 + s8 * 8 + j;
        const float nxt = has_next(t) ? bf2f(XBC[(size_t)(t + 1) * 4096 + c]) : 0.f;
        o[j] = silu(bb + w0 * prev + w1 * cur + w2 * nxt);
        prev = cur; cur = nxt;
      }
      u32x4 v = {pk2(o[0], o[1]), pk2(o[2], o[3]), pk2(o[4], o[5]), pk2(o[6], o[7])};
      *(u32x4*)(XT + ((size_t)chunk * 2048 + c) * 128 + sg * 32 + s8 * 8) = v;
    }
  }
  for (int i = obid() * 256 + tid; i < (T / 4) * 256; i += VGRID * 256) {
    const int t0 = (i >> 8) * 4, c8 = (i & 255) * 8;
    const int c = 2048 + c8;
    const bool hp = has_prev(t0), hn = has_next(t0 + 3);
    const u32x4 zero4 = {0u, 0u, 0u, 0u};
    u32x4 rr[6];
#pragma unroll
    for (int r = 0; r < 6; ++r) {
      const bool valid = (r == 0) ? hp : (r == 5) ? hn : true;
      rr[r] = valid ? *(const u32x4*)(XBC + (size_t)(t0 - 1 + r) * 4096 + c) : zero4;
    }
    float w0[8], w1[8], w2[8], bb[8];
    {
      const f32x4 a0 = *(const f32x4*)(cw + c), a1 = *(const f32x4*)(cw + c + 4);
      const f32x4 b0 = *(const f32x4*)(cw + 4096 + c), b1 = *(const f32x4*)(cw + 4096 + c + 4);
      const f32x4 c0 = *(const f32x4*)(cw + 8192 + c), c1 = *(const f32x4*)(cw + 8192 + c + 4);
      const f32x4 d0 = *(const f32x4*)(cb + c), d1 = *(const f32x4*)(cb + c + 4);
      w0[0] = a0.x; w0[1] = a0.y; w0[2] = a0.z; w0[3] = a0.w; w0[4] = a1.x; w0[5] = a1.y; w0[6] = a1.z; w0[7] = a1.w;
      w1[0] = b0.x; w1[1] = b0.y; w1[2] = b0.z; w1[3] = b0.w; w1[4] = b1.x; w1[5] = b1.y; w1[6] = b1.z; w1[7] = b1.w;
      w2[0] = c0.x; w2[1] = c0.y; w2[2] = c0.z; w2[3] = c0.w; w2[4] = c1.x; w2[5] = c1.y; w2[6] = c1.z; w2[7] = c1.w;
      bb[0] = d0.x; bb[1] = d0.y; bb[2] = d0.z; bb[3] = d0.w; bb[4] = d1.x; bb[5] = d1.y; bb[6] = d1.z; bb[7] = d1.w;
    }
#pragma unroll
    for (int k = 0; k < 4; ++k) {
      float xp[8], xc[8], xn[8], o[8];
      unpack8(rr[k], xp); unpack8(rr[k + 1], xc); unpack8(rr[k + 2], xn);
#pragma unroll
      for (int j = 0; j < 8; ++j) o[j] = silu(bb[j] + w0[j] * xp[j] + w1[j] * xc[j] + w2[j] * xn[j]);
      u32x4 v = {pk2(o[0], o[1]), pk2(o[2], o[3]), pk2(o[4], o[5]), pk2(o[6], o[7])};
      if (c8 < 1024) *(u32x4*)(Bm + (size_t)(t0 + k) * 1024 + c8) = v;
      else *(u32x4*)(Cm + (size_t)(t0 + k) * 1024 + c8 - 1024) = v;
    }
  }
}

DI void ssd_fix_phase(const bf16_t* __restrict__ UE, const float* __restrict__ cw, const float* __restrict__ cb,
                      bf16_t* __restrict__ XT, bf16_t* __restrict__ Bm, bf16_t* __restrict__ Cm) {
  for (int i = obid() * 256 + otid(); i < 128 * 2 * 512; i += VGRID * 256) {
    const int cc = (i & 511) * 8, k = (i >> 9) & 1, chunk = i >> 10;
    const int s = k ? 127 : 0, t = chunk * 128 + s;
    const bf16_t* base = UE + (size_t)chunk * 4 * 4096 + cc;
    const u32x4 zero4 = {0u, 0u, 0u, 0u};
    u32x4 pv, cv, nv;
    if (k == 0) {
      pv = has_prev(t) ? *(const u32x4*)(base - 4096) : zero4;
      cv = *(const u32x4*)base; nv = *(const u32x4*)(base + 4096);
    } else {
      pv = *(const u32x4*)(base + 2 * 4096); cv = *(const u32x4*)(base + 3 * 4096);
      nv = has_next(t) ? *(const u32x4*)(base + 4 * 4096) : zero4;
    }
    float xp[8], xc[8], xn[8], o[8];
    unpack8(pv, xp); unpack8(cv, xc); unpack8(nv, xn);
#pragma unroll
    for (int j = 0; j < 8; ++j) o[j] = silu(cb[cc + j] + cw[cc + j] * xp[j] + cw[4096 + cc + j] * xc[j] + cw[8192 + cc + j] * xn[j]);
    if (cc < 2048) {
#pragma unroll
      for (int j = 0; j < 8; ++j) XT[((size_t)chunk * 2048 + cc + j) * 128 + s] = f2bf(o[j]);
    } else {
      u32x4 v = {pk2(o[0], o[1]), pk2(o[2], o[3]), pk2(o[4], o[5]), pk2(o[6], o[7])};
      if (cc < 3072) *(u32x4*)(Bm + (size_t)t * 1024 + cc - 2048) = v;
      else *(u32x4*)(Cm + (size_t)t * 1024 + cc - 3072) = v;
    }
  }
}

DI void ssd_cumsum_phase(const float* __restrict__ DT, const float* __restrict__ a_log, float* __restrict__ ACST,
                         float* __restrict__ BST, float* __restrict__ WST, float* __restrict__ DEC) {
  for (int i = obid() * 256 + otid(); i < 128 * 64; i += VGRID * 256) {
    const int chunk = i >> 6, hd = i & 63;
    const float a = -__expf(a_log[hd]);
    const float* dp = DT + (size_t)(chunk * 128) * 64 + hd;
    float tot = 0.f;
#pragma unroll 1
    for (int b = 0; b < 8; ++b) {
      float d[16];
#pragma unroll
      for (int k = 0; k < 16; ++k) d[k] = dp[(size_t)(16 * b + k) * 64];
#pragma unroll
      for (int k = 0; k < 16; ++k) tot += d[k] * a;
    }
    const bool bwd = hd >= 32;
    float run = 0.f;
    float* pa = ACST + (size_t)i * 128; float* pb = BST + (size_t)i * 128; float* pw = WST + (size_t)i * 128;
#pragma unroll 1
    for (int b = 0; b < 8; ++b) {
      float d[16];
#pragma unroll
      for (int k = 0; k < 16; ++k) { const int s = bwd ? 127 - (16 * b + k) : 16 * b + k; d[k] = dp[(size_t)s * 64]; }
#pragma unroll
      for (int k = 0; k < 16; ++k) {
        const int s = bwd ? 127 - (16 * b + k) : 16 * b + k;
        run += d[k] * a;
        pa[s] = run;
        pb[s] = run - __logf(d[k]);
        pw[s] = __expf(tot - run) * d[k];
      }
    }
    DEC[i] = __expf(tot);
  }
}

DI void ssd_states_phase(const bf16_t* __restrict__ XT, const bf16_t* __restrict__ Bm, const float* __restrict__ WST,
                         bf16_t* __restrict__ S, char* smem) {
  bf16_t* sBT = (bf16_t*)smem;
  const int tid = otid(), lane = tid & 63, w = tid >> 6, l31 = lane & 31, half = lane >> 5;
  for (int it = obid(); it < 1024; it += VGRID) {
    const int chunk = it >> 3, g = it & 7, t0 = chunk * 128;
    __syncthreads();
#pragma unroll 2
    for (int idx = tid; idx < 128 * 16; idx += 256) {
      const int s = idx >> 4, n8 = (idx & 15) * 8;
      const u32x4 v = *(const u32x4*)(Bm + (size_t)(t0 + s) * 1024 + g * 128 + n8);
      bf16_t* dp = sBT + n8 * 136 + s;
      dp[0 * 136] = (bf16_t)(v.x & 0xffff); dp[1 * 136] = (bf16_t)(v.x >> 16);
      dp[2 * 136] = (bf16_t)(v.y & 0xffff); dp[3 * 136] = (bf16_t)(v.y >> 16);
      dp[4 * 136] = (bf16_t)(v.z & 0xffff); dp[5 * 136] = (bf16_t)(v.z >> 16);
      dp[6 * 136] = (bf16_t)(v.w & 0xffff); dp[7 * 136] = (bf16_t)(v.w >> 16);
    }
    __syncthreads();
    const int h = g * 4 + w;
    u32x4 xa[2][8];
    const bf16_t* xbase = XT + ((size_t)chunk * 2048 + h * 64 + l31) * 128 + 8 * half;
#pragma unroll
    for (int mt = 0; mt < 2; ++mt)
#pragma unroll
      for (int ks = 0; ks < 8; ++ks) xa[mt][ks] = *(const u32x4*)(xbase + mt * 32 * 128 + 16 * ks);
    const bf16_t* bbase = sBT + l31 * 136 + 8 * half;
#pragma unroll 1
    for (int dn = 0; dn < 4; ++dn) {
      const int d = dn >> 1, nh = dn & 1;
      const int hd = d * 32 + h;
      f32x16 acc[2][2];
#pragma unroll
      for (int i = 0; i < 2; ++i)
#pragma unroll
        for (int j = 0; j < 2; ++j) zero16(acc[i][j]);
      const float* wp = WST + ((size_t)chunk * 64 + hd) * 128 + 8 * half;
      const bf16_t* bb = bbase + (64 * nh) * 136;
#pragma unroll
      for (int ks = 0; ks < 8; ++ks) {
        const f32x4 w0 = *(const f32x4*)(wp + 16 * ks);
        const f32x4 w1 = *(const f32x4*)(wp + 16 * ks + 4);
        bf16x8 a[2];
#pragma unroll
        for (int mt = 0; mt < 2; ++mt) {
          const u32x4 xv = xa[mt][ks];
          a[mt] = pack8(lo_f(xv.x) * w0.x, hi_f(xv.x) * w0.y, lo_f(xv.y) * w0.z, hi_f(xv.y) * w0.w,
                        lo_f(xv.z) * w1.x, hi_f(xv.z) * w1.y, lo_f(xv.w) * w1.z, hi_f(xv.w) * w1.w);
        }
#pragma unroll
        for (int nt = 0; nt < 2; ++nt) {
          const bf16x8 b = ld8(bb + (32 * nt) * 136 + 16 * ks);
          acc[0][nt] = MFMA(a[0], b, acc[0][nt]);
          acc[1][nt] = MFMA(a[1], b, acc[1][nt]);
        }
      }
      bf16_t* sp = S + (((size_t)chunk * 2 + d) * 32 + h) * 8192 + (4 * half) * 128 + 64 * nh + l31;
#pragma unroll
      for (int mt = 0; mt < 2; ++mt)
#pragma unroll
        for (int nt = 0; nt < 2; ++nt)
#pragma unroll
          for (int i = 0; i < 16; ++i) sp[(32 * mt + (i & 3) + 8 * (i >> 2)) * 128 + 32 * nt] = f2bf(acc[mt][nt][i]);
    }
  }
}

template <int NC>
DI void scan_item(bf16_t* __restrict__ S, const float* __restrict__ DEC, float (&hc)[8], int cbase, int d, int h, int pp, int n8) {
  u32x4 v[NC];
  float dec[NC];
#pragma unroll
  for (int ci = 0; ci < NC; ++ci) {
    const int chunk = cbase + (d == 0 ? ci : NC - 1 - ci);
    v[ci] = *(const u32x4*)(S + ((((size_t)chunk * 2 + d) * 32 + h) * 64 + pp) * 128 + n8);
    dec[ci] = DEC[chunk * 64 + d * 32 + h];
  }
#pragma unroll
  for (int ci = 0; ci < NC; ++ci) {
    const int chunk = cbase + (d == 0 ? ci : NC - 1 - ci);
    float tmp[8];
    unpack8(v[ci], tmp);
    u32x4 o = {pk2(hc[0], hc[1]), pk2(hc[2], hc[3]), pk2(hc[4], hc[5]), pk2(hc[6], hc[7])};
    *(u32x4*)(S + ((((size_t)chunk * 2 + d) * 32 + h) * 64 + pp) * 128 + n8) = o;
#pragma unroll
    for (int q = 0; q < 8; ++q) hc[q] = hc[q] * dec[ci] + tmp[q];
  }
}
DI void ssd_scan_phase(bf16_t* __restrict__ S, const float* __restrict__ DEC, const float* __restrict__ state_ssm, int j, float* __restrict__ out_state) {
  for (int idx = obid() * 256 + otid(); idx < 36 * 65536; idx += VGRID * 256) {
    const int n8 = (idx & 15) * 8, pp = (idx >> 4) & 63, h = (idx >> 10) & 31, d = (idx >> 15) & 1, seq = idx >> 16;
    float hc[8];
    if (seq < 32) {
      float zz = 0.f;
      asm volatile("" : "+v"(zz));
#pragma unroll
      for (int q = 0; q < 8; ++q) hc[q] = zz;
      scan_item<2>(S, DEC, hc, seq * 2, d, h, pp, n8);
      float* op = out_state + ((((size_t)seq * 2 + j) * 2 + d) * 32 + h) * 8192 + pp * 128 + n8;
      f32x4 a = {hc[0], hc[1], hc[2], hc[3]}, b = {hc[4], hc[5], hc[6], hc[7]};
      __builtin_nontemporal_store(a, (f32x4*)op); __builtin_nontemporal_store(b, (f32x4*)(op + 4));
    } else {
      const float* sp = state_ssm + ((((size_t)(seq - 32) * 2 + j) * 2 + d) * 32 + h) * 8192 + pp * 128 + n8;
      const f32x4 a = *(const f32x4*)sp, b = *(const f32x4*)(sp + 4);
      hc[0] = a.x; hc[1] = a.y; hc[2] = a.z; hc[3] = a.w; hc[4] = b.x; hc[5] = b.y; hc[6] = b.z; hc[7] = b.w;
      scan_item<16>(S, DEC, hc, 64 + (seq - 32) * 16, d, h, pp, n8);
    }
  }
}

DI void ssd_y_phase(const bf16_t* __restrict__ XT, const bf16_t* __restrict__ Bm, const bf16_t* __restrict__ Cm, const bf16_t* __restrict__ S,
                    const float* __restrict__ ACST, const float* __restrict__ BST, const float* __restrict__ dskip, bf16_t* Z, char* smem) {
  constexpr int RS = 272;
  constexpr int TB = 64 * RS;
  const int tid = otid(), lane = tid & 63, w = tid >> 6, l31 = lane & 31, half = lane >> 5;
  for (int it = obid(); it < 1024; it += VGRID) {
    const int chunk = it >> 3, g = it & 7, t0 = chunk * 128;
    const int qc = 32 * w + l31;
    bf16x8 cmf[8];
    {
      const bf16_t* cp = Cm + (size_t)(t0 + qc) * 1024 + g * 128 + 8 * half;
#pragma unroll
      for (int ks = 0; ks < 8; ++ks) cmf[ks] = ld8(cp + 16 * ks);
    }
    f32x16 cbt[4];
#pragma unroll
    for (int mt = 0; mt < 4; ++mt) zero16(cbt[mt]);
    {
      const bf16_t* bp = Bm + (size_t)(t0 + l31) * 1024 + g * 128 + 8 * half;
#pragma unroll
      for (int ks = 0; ks < 8; ++ks) {
#pragma unroll
        for (int mt = 0; mt < 4; ++mt) {
          const bf16x8 a = ld8(bp + (size_t)(32 * mt) * 1024 + 16 * ks);
          cbt[mt] = MFMA(a, cmf[ks], cbt[mt]);
        }
      }
    }
#pragma unroll 1
    for (int r = 0; r < 4; ++r) {
      const int h = g * 4 + r;
      __syncthreads();
      {
        const bf16_t* src0 = XT + ((size_t)chunk * 2048 + h * 64) * 128;
        const bf16_t* src1 = S + (((size_t)chunk * 2 + 0) * 32 + h) * 8192;
        const bf16_t* src2 = S + (((size_t)chunk * 2 + 1) * 32 + h) * 8192;
        u32x4 v0[4], v1[4], v2[4];
#pragma unroll
        for (int i = 0; i < 4; ++i) {
          const int idx = tid + 256 * i;
          v0[i] = *(const u32x4*)(src0 + idx * 8);
          v1[i] = *(const u32x4*)(src1 + idx * 8);
          v2[i] = *(const u32x4*)(src2 + idx * 8);
        }
#pragma unroll
        for (int i = 0; i < 4; ++i) {
          const int idx = tid + 256 * i;
          char* dp = smem + (idx >> 4) * RS + (idx & 15) * 16;
          *(u32x4*)dp = v0[i];
          *(u32x4*)(dp + TB) = v1[i];
          *(u32x4*)(dp + 2 * TB) = v2[i];
        }
      }
      __syncthreads();
      f32x16 yd[2];
      zero16(yd[0]); zero16(yd[1]);
#pragma unroll 1
      for (int d = 0; d < 2; ++d) {
        const int hd = d * 32 + h;
        const float* acsp = ACST + ((size_t)chunk * 64 + hd) * 128;
        const float* bsp = BST + ((size_t)chunk * 64 + hd) * 128 + 4 * half;
        const float aq = acsp[qc];
        f32x16 yo[2];
        zero16(yo[0]); zero16(yo[1]);
        const char* sp = smem + (1 + d) * TB + l31 * RS + 16 * half;
#pragma unroll
        for (int ks = 0; ks < 8; ++ks) {
#pragma unroll
          for (int nt = 0; nt < 2; ++nt) {
            const bf16x8 bfr = *(const bf16x8*)(sp + (32 * nt) * RS + 32 * ks);
            yo[nt] = MFMA(cmf[ks], bfr, yo[nt]);
          }
        }
#pragma unroll
        for (int qd = 0; qd < 4; ++qd) {
          const f32x4 e4 = *(const f32x4*)(acsp + 32 * w + 8 * qd + 4 * half);
          const float e0 = __expf(e4.x), e1 = __expf(e4.y), e2 = __expf(e4.z), e3 = __expf(e4.w);
#pragma unroll
          for (int nt = 0; nt < 2; ++nt) {
            yd[nt][4 * qd + 0] += e0 * yo[nt][4 * qd + 0]; yd[nt][4 * qd + 1] += e1 * yo[nt][4 * qd + 1];
            yd[nt][4 * qd + 2] += e2 * yo[nt][4 * qd + 2]; yd[nt][4 * qd + 3] += e3 * yo[nt][4 * qd + 3];
          }
        }
        const char* xtp = smem + l31 * RS + 8 * half;
#pragma unroll
        for (int mt = 0; mt < 4; ++mt) {
          const bool need = (d == 0) ? (mt <= w) : (mt >= w);
          if (need) {
#pragma unroll
            for (int ss = 0; ss < 2; ++ss) {
              const int sb = 32 * mt + 16 * ss;
              const f32x4 b0 = *(const f32x4*)(bsp + sb);
              const f32x4 b1 = *(const f32x4*)(bsp + sb + 8);
              const float bsv[8] = {b0.x, b0.y, b0.z, b0.w, b1.x, b1.y, b1.z, b1.w};
              float lv[8];
#pragma unroll
              for (int jj = 0; jj < 8; ++jj) {
                const int s = sb + 4 * half + (jj & 3) + 8 * (jj >> 2);
                const bool ok = (d == 0) ? (s <= qc) : (s >= qc);
                const float arg = ok ? (aq - bsv[jj]) : -1e30f;
                lv[jj] = cbt[mt][8 * ss + jj] * __expf(arg);
              }
              const bf16x8 xa = pack8(lv[0], lv[1], lv[2], lv[3], lv[4], lv[5], lv[6], lv[7]);
#pragma unroll
              for (int nt = 0; nt < 2; ++nt) {
                const char* xp = xtp + (32 * nt) * RS + sb * 2;
                const u32x2 lo = *(const u32x2*)xp, hi = *(const u32x2*)(xp + 16);
                u32x4 xv = {lo.x, lo.y, hi.x, hi.y};
                yd[nt] = MFMA(xa, __builtin_bit_cast(bf16x8, xv), yd[nt]);
              }
            }
          }
        }
      }
      const float dsk = dskip[h];
#pragma unroll
      for (int nt = 0; nt < 2; ++nt) {
        const int c = h * 64 + 32 * nt + l31;
        const char* xq = smem + (32 * nt + l31) * RS + (32 * w + 4 * half) * 2;
        bf16_t* zp = Z + (size_t)(t0 + 32 * w + 4 * half) * 2048 + c;
#pragma unroll
        for (int qd = 0; qd < 4; ++qd) {
          const u32x2 xv = *(const u32x2*)(xq + 16 * qd);
          const float xs[4] = {lo_f(xv.x), hi_f(xv.x), lo_f(xv.y), hi_f(xv.y)};
#pragma unroll
          for (int e = 0; e < 4; ++e) {
            bf16_t* zz = zp + (size_t)(8 * qd + e) * 2048;
            const float zv = bf2f(*zz);
            const float y = yd[nt][4 * qd + e] + dsk * xs[e];
            *zz = f2bf(y * silu(zv));
          }
        }
      }
    }
  }
  __syncthreads();
}

DI void ssq_phase(const bf16_t* __restrict__ YZ, float* __restrict__ RSTD) {
  const int lane = otid() & 63;
  const int wid = obid() * 4 + (otid() >> 6), nw = VGRID * 4;
  for (int t = wid; t < T; t += nw) {
    float ssq = 0.f;
#pragma unroll
    for (int j = 0; j < 4; ++j) {
      float v[8];
      unpack8(*(const u32x4*)(YZ + (size_t)t * 2048 + lane * 8 + 512 * j), v);
#pragma unroll
      for (int q = 0; q < 8; ++q) ssq += v[q] * v[q];
    }
    ssq = wave_sum(ssq);
    if (lane == 0) RSTD[t] = rsqrtf(ssq * (1.f / 2048.f) + EPS);
  }
}

DI void sc_mid_phase(const bf16_t* __restrict__ BCU, const float* __restrict__ cw, bf16_t* __restrict__ H) {
  for (int i = obid() * 256 + otid(); i < (T / 4) * 128; i += VGRID * 256) {
    const int t0 = (i >> 7) * 4, c = (i & 127) * 8;
    const bool hp = has_prev(t0), hn = has_next(t0 + 3);
    const u32x4 zero4 = {0u, 0u, 0u, 0u};
    u32x4 ar[6], br[6], gr[4];
#pragma unroll
    for (int r = 0; r < 6; ++r) {
      const bool valid = (r == 0) ? hp : (r == 5) ? hn : true;
      const bf16_t* p = BCU + (size_t)(t0 - 1 + r) * 3072 + c;
      ar[r] = valid ? *(const u32x4*)(p + 1024) : zero4;
      br[r] = valid ? *(const u32x4*)(p + 2048) : zero4;
    }
#pragma unroll
    for (int k = 0; k < 4; ++k) gr[k] = *(const u32x4*)(BCU + (size_t)(t0 + k) * 3072 + c);
    float w0[8], w1[8], w2[8];
    {
      const f32x4 a0 = *(const f32x4*)(cw + c), a1 = *(const f32x4*)(cw + c + 4);
      const f32x4 b0 = *(const f32x4*)(cw + 1024 + c), b1 = *(const f32x4*)(cw + 1024 + c + 4);
      const f32x4 c0 = *(const f32x4*)(cw + 2048 + c), c1 = *(const f32x4*)(cw + 2048 + c + 4);
      w0[0] = a0.x; w0[1] = a0.y; w0[2] = a0.z; w0[3] = a0.w; w0[4] = a1.x; w0[5] = a1.y; w0[6] = a1.z; w0[7] = a1.w;
      w1[0] = b0.x; w1[1] = b0.y; w1[2] = b0.z; w1[3] = b0.w; w1[4] = b1.x; w1[5] = b1.y; w1[6] = b1.z; w1[7] = b1.w;
      w2[0] = c0.x; w2[1] = c0.y; w2[2] = c0.z; w2[3] = c0.w; w2[4] = c1.x; w2[5] = c1.y; w2[6] = c1.z; w2[7] = c1.w;
    }
#pragma unroll
    for (int k = 0; k < 4; ++k) {
      float a0[8], b0[8], a1[8], b1[8], a2[8], b2[8], bg[8], o[8];
      unpack8(ar[k], a0); unpack8(br[k], b0); unpack8(ar[k + 1], a1); unpack8(br[k + 1], b1); unpack8(ar[k + 2], a2); unpack8(br[k + 2], b2);
      unpack8(gr[k], bg);
#pragma unroll
      for (int j = 0; j < 8; ++j) o[j] = bg[j] * (w0[j] * (a0[j] * b0[j]) + w1[j] * (a1[j] * b1[j]) + w2[j] * (a2[j] * b2[j]));
      u32x4 v = {pk2(o[0], o[1]), pk2(o[2], o[3]), pk2(o[4], o[5]), pk2(o[6], o[7])};
      *(u32x4*)(H + (size_t)(t0 + k) * 1024 + c) = v;
    }
  }
}

DI void ffn_gate_phase(const bf16_t* __restrict__ U, const float* __restrict__ cw, bf16_t* __restrict__ G) {
  for (int i = obid() * 256 + otid(); i < (T / 4) * 352; i += VGRID * 256) {
    const int tb = i / 352, c = (i - tb * 352) * 8, t0 = tb * 4;
    const bool hp = has_prev(t0), hn = has_next(t0 + 3);
    u32x4 gr[6], vr[6];
    const u32x4 zero4 = {0u, 0u, 0u, 0u};
#pragma unroll
    for (int r = 0; r < 6; ++r) {
      const bool valid = (r == 0) ? hp : (r == 5) ? hn : true;
      const bf16_t* up = U + (size_t)(t0 - 1 + r) * 5632 + c;
      gr[r] = valid ? *(const u32x4*)up : zero4;
      vr[r] = valid ? *(const u32x4*)(up + 2816) : zero4;
    }
    float wg[3][8], wv[3][8];
#pragma unroll
    for (int k = 0; k < 3; ++k) {
      const f32x4 a0 = *(const f32x4*)(cw + k * 5632 + c), a1 = *(const f32x4*)(cw + k * 5632 + c + 4);
      const f32x4 b0 = *(const f32x4*)(cw + k * 5632 + 2816 + c), b1 = *(const f32x4*)(cw + k * 5632 + 2816 + c + 4);
      wg[k][0] = a0.x; wg[k][1] = a0.y; wg[k][2] = a0.z; wg[k][3] = a0.w; wg[k][4] = a1.x; wg[k][5] = a1.y; wg[k][6] = a1.z; wg[k][7] = a1.w;
      wv[k][0] = b0.x; wv[k][1] = b0.y; wv[k][2] = b0.z; wv[k][3] = b0.w; wv[k][4] = b1.x; wv[k][5] = b1.y; wv[k][6] = b1.z; wv[k][7] = b1.w;
    }
#pragma unroll
    for (int k = 0; k < 4; ++k) {
      float g0[8], g1[8], g2[8], v0[8], v1[8], v2[8], o[8];
      unpack8(gr[k], g0); unpack8(gr[k + 1], g1); unpack8(gr[k + 2], g2);
      unpack8(vr[k], v0); unpack8(vr[k + 1], v1); unpack8(vr[k + 2], v2);
#pragma unroll
      for (int j = 0; j < 8; ++j) {
        const float gg = wg[0][j] * g0[j] + wg[1][j] * g1[j] + wg[2][j] * g2[j];
        const float vv = wv[0][j] * v0[j] + wv[1][j] * v1[j] + wv[2][j] * v2[j];
        o[j] = silu(gg) * vv;
      }
      u32x4 ov = {pk2(o[0], o[1]), pk2(o[2], o[3]), pk2(o[4], o[5]), pk2(o[6], o[7])};
      *(u32x4*)(G + (size_t)(t0 + k) * 2816 + c) = ov;
    }
  }
}

DI void ffn_fix_phase(const bf16_t* __restrict__ UE, const float* __restrict__ cw, bf16_t* __restrict__ G) {
  for (int i = obid() * 256 + otid(); i < 128 * 2 * 352; i += VGRID * 256) {
    const int c = (i % 352) * 8, k = (i / 352) & 1, wt = i / 704;
    const int t = wt * 128 + (k ? 127 : 0);
    const int pc = (c >> 5) * 64 + (c & 31);
    const bf16_t* base = UE + (size_t)wt * 4 * 5632 + pc;
    const u32x4 zero4 = {0u, 0u, 0u, 0u};
    u32x4 gpv, gcv, gnv, vpv, vcv, vnv;
    if (k == 0) {
      const bool hp = has_prev(t);
      gpv = hp ? *(const u32x4*)(base - 5632) : zero4;
      vpv = hp ? *(const u32x4*)(base - 5632 + 32) : zero4;
      gcv = *(const u32x4*)base; vcv = *(const u32x4*)(base + 32);
      gnv = *(const u32x4*)(base + 5632); vnv = *(const u32x4*)(base + 5632 + 32);
    } else {
      const bool hn = has_next(t);
      gpv = *(const u32x4*)(base + 2 * 5632); vpv = *(const u32x4*)(base + 2 * 5632 + 32);
      gcv = *(const u32x4*)(base + 3 * 5632); vcv = *(const u32x4*)(base + 3 * 5632 + 32);
      gnv = hn ? *(const u32x4*)(base + 4 * 5632) : zero4;
      vnv = hn ? *(const u32x4*)(base + 4 * 5632 + 32) : zero4;
    }
    float gp[8], gc[8], gn[8], vp[8], vc[8], vn[8], o[8];
    unpack8(gpv, gp); unpack8(gcv, gc); unpack8(gnv, gn); unpack8(vpv, vp); unpack8(vcv, vc); unpack8(vnv, vn);
#pragma unroll
    for (int j = 0; j < 8; ++j) {
      const float gg = cw[c + j] * gp[j] + cw[5632 + c + j] * gc[j] + cw[11264 + c + j] * gn[j];
      const float vv = cw[2816 + c + j] * vp[j] + cw[5632 + 2816 + c + j] * vc[j] + cw[11264 + 2816 + c + j] * vn[j];
      o[j] = silu(gg) * vv;
    }
    u32x4 ov = {pk2(o[0], o[1]), pk2(o[2], o[3]), pk2(o[4], o[5]), pk2(o[6], o[7])};
    *(u32x4*)(G + (size_t)t * 2816 + c) = ov;
  }
}

DI void cache_phase(const float* __restrict__ ck, const float* __restrict__ cv, bf16_t* __restrict__ KB, bf16_t* __restrict__ VT) {
  for (int i = obid() * 256 + otid(); i < 4 * 256 * 1024; i += VGRID * 256) {
    const int c = i & 1023, jk = (i >> 10) & 255, b = i >> 18;
    KB[(size_t)(TP + b * 2304 + jk) * 1024 + c] = f2bf(ck[i]);
    VT[(size_t)TP * 1024 + (size_t)b * 1024 * 2304 + (size_t)c * 2304 + jk] = f2bf(cv[i]);
  }
}

DI void attn_phase(const bf16_t* __restrict__ Q, const bf16_t* __restrict__ KB, const bf16_t* __restrict__ VT, bf16_t* __restrict__ O,
                   const float* __restrict__ gsub, float lam, float lam_init, char* smem) {
  constexpr int KRS = 272, VRS = 72;
  constexpr int KB_BYTES = 32 * KRS;
  constexpr int BUF = KB_BYTES + 128 * VRS;
  const int tid = otid(), lane = tid & 63, w = tid >> 6, l31 = lane & 31, half = lane >> 5;
  const int krow0 = tid >> 4, kc = tid & 15;
  const int vrow0 = tid >> 2, vc = tid & 3;
  for (int it = obid(); it < 1024; it += VGRID) {
    int seqt0, kb0, L, hp, qb; size_t vbase;
    if (it < 512) { const int b = it >> 7; hp = (it >> 4) & 7; qb = it & 15; seqt0 = TP + b * 2048; kb0 = TP + b * 2304; L = 2304; vbase = (size_t)TP * 1024 + (size_t)b * 1024 * 2304; }
    else { const int i2 = it - 512; const int s = i2 >> 4; hp = (i2 >> 1) & 7; qb = i2 & 1; seqt0 = s * 256; kb0 = s * 256; L = 256; vbase = (size_t)s * 1024 * 256; }
    const int tq = seqt0 + qb * 128 + w * 32 + l31;
    const int ntile = L >> 5;
    bf16x8 qf0[4], qf1[4];
    {
      const bf16_t* qp = Q + (size_t)tq * 1024 + (2 * hp) * 64 + 8 * half;
#pragma unroll
      for (int ks = 0; ks < 4; ++ks) { qf0[ks] = ld8(qp + 16 * ks); qf1[ks] = ld8(qp + 64 + 16 * ks); }
    }
    const bf16_t* kg = KB + (size_t)(kb0 + krow0) * 1024 + (2 * hp) * 64 + kc * 8;
    const bf16_t* vg = VT + vbase + (size_t)(hp * 128 + vrow0) * L + vc * 8;
    char* kdst = smem + krow0 * KRS + kc * 16;
    char* vdst = smem + KB_BYTES + vrow0 * VRS + vc * 16;
    const char* kfr = smem + l31 * KRS + 16 * half;
    const char* vfr = smem + KB_BYTES + l31 * VRS + 8 * half;

    float m0 = -1e30f, m1 = -1e30f, l0 = 0.f, l1 = 0.f;
#define ATT_QK(s0_, s1_, cur_)                                                              \
    do {                                                                                    \
      zero16(s0_); zero16(s1_);                                                             \
      _Pragma("unroll") for (int ks = 0; ks < 4; ++ks) {                                    \
        const bf16x8 a0 = *(const bf16x8*)(kfr + (cur_) + 32 * ks);                         \
        s0_ = MFMA(a0, qf0[ks], s0_);                                                            \
      }                                                                                     \
      __builtin_amdgcn_sched_barrier(0);                                                    \
      _Pragma("unroll") for (int ks = 0; ks < 4; ++ks) {                                    \
        const bf16x8 a1 = *(const bf16x8*)(kfr + (cur_) + 128 + 32 * ks);                   \
        s1_ = MFMA(a1, qf1[ks], s1_);                                                            \
      }                                                                                     \
      __builtin_amdgcn_sched_barrier(0);                                                    \
    } while (0)
    __syncthreads();
    {
      const u32x4 k0 = *(const u32x4*)kg, k1 = *(const u32x4*)(kg + 16 * 1024);
      *(u32x4*)kdst = k0; *(u32x4*)(kdst + 16 * KRS) = k1;
    }
    __syncthreads();
#pragma unroll 1
    for (int ti = 0; ti < ntile; ++ti) {
      const int cur = (ti & 1) * BUF, nxt = BUF - cur;
      const bool more = ti + 1 < ntile;
      u32x4 k0, k1;
      if (more) {
        const bf16_t* kq = kg + (size_t)(ti + 1) * 32 * 1024;
        k0 = *(const u32x4*)kq; k1 = *(const u32x4*)(kq + 16 * 1024);
      }
      f32x16 s0, s1;
      ATT_QK(s0, s1, cur);
      float x0 = s0[0], x1 = s1[0];
#pragma unroll
      for (int i = 1; i < 16; ++i) { x0 = fmaxf(x0, s0[i]); x1 = fmaxf(x1, s1[i]); }
      const float n0 = fmaxf(m0, x0), n1 = fmaxf(m1, x1);
      float p0 = 0.f, p1 = 0.f;
#pragma unroll
      for (int i = 0; i < 16; ++i) { p0 += __expf(s0[i] - n0); p1 += __expf(s1[i] - n1); }
      l0 = l0 * __expf(m0 - n0) + p0; m0 = n0;
      l1 = l1 * __expf(m1 - n1) + p1; m1 = n1;
      if (more) { *(u32x4*)(kdst + nxt) = k0; *(u32x4*)(kdst + nxt + 16 * KRS) = k1; }
      __syncthreads();
    }
    {
      const float mo0 = shx(m0, 32), lo0 = shx(l0, 32);
      const float mo1 = shx(m1, 32), lo1 = shx(l1, 32);
      const float M0 = fmaxf(m0, mo0), M1 = fmaxf(m1, mo1);
      l0 = l0 * __expf(m0 - M0) + lo0 * __expf(mo0 - M0); m0 = M0;
      l1 = l1 * __expf(m1 - M1) + lo1 * __expf(mo1 - M1); m1 = M1;
    }
    const float c0 = 1.f / l0, c1 = -lam / l1;
    f32x16 o[4];
#pragma unroll
    for (int et = 0; et < 4; ++et) zero16(o[et]);
    {
      const u32x4 k0 = *(const u32x4*)kg, k1 = *(const u32x4*)(kg + 16 * 1024);
      const u32x4 v0 = *(const u32x4*)vg, v1 = *(const u32x4*)(vg + (size_t)64 * L);
      *(u32x4*)kdst = k0; *(u32x4*)(kdst + 16 * KRS) = k1;
      u32x2 a = {v0.x, v0.y}, b = {v0.z, v0.w}, c = {v1.x, v1.y}, d = {v1.z, v1.w};
      *(u32x2*)vdst = a; *(u32x2*)(vdst + 8) = b; *(u32x2*)(vdst + 64 * VRS) = c; *(u32x2*)(vdst + 64 * VRS + 8) = d;
    }
    __syncthreads();
#pragma unroll 1
    for (int ti = 0; ti < ntile; ++ti) {
      const int cur = (ti & 1) * BUF, nxt = BUF - cur;
      const bool more = ti + 1 < ntile;
      u32x4 k0, k1, v0, v1;
      if (more) {
        const bf16_t* kq = kg + (size_t)(ti + 1) * 32 * 1024;
        k0 = *(const u32x4*)kq; k1 = *(const u32x4*)(kq + 16 * 1024);
        const bf16_t* vq = vg + (ti + 1) * 32;
        v0 = *(const u32x4*)vq; v1 = *(const u32x4*)(vq + (size_t)64 * L);
      }
      f32x16 s0, s1;
      ATT_QK(s0, s1, cur);
#pragma unroll
      for (int i = 0; i < 16; ++i) s0[i] = c0 * __expf(s0[i] - m0) + c1 * __expf(s1[i] - m1);
#pragma unroll
      for (int ss = 0; ss < 2; ++ss) {
        const bf16x8 pb = pack8(s0[8 * ss + 0], s0[8 * ss + 1], s0[8 * ss + 2], s0[8 * ss + 3],
                                s0[8 * ss + 4], s0[8 * ss + 5], s0[8 * ss + 6], s0[8 * ss + 7]);
#pragma unroll
        for (int et = 0; et < 4; ++et) {
          const char* vq = vfr + cur + (32 * et) * VRS + 32 * ss;
          const u32x2 lo = *(const u32x2*)vq, hi = *(const u32x2*)(vq + 16);
          u32x4 vv = {lo.x, lo.y, hi.x, hi.y};
          o[et] = MFMA(__builtin_bit_cast(bf16x8, vv), pb, o[et]);
        }
      }
      if (more) {
        *(u32x4*)(kdst + nxt) = k0; *(u32x4*)(kdst + nxt + 16 * KRS) = k1;
        u32x2 a = {v0.x, v0.y}, b = {v0.z, v0.w}, c = {v1.x, v1.y}, d = {v1.z, v1.w};
        *(u32x2*)(vdst + nxt) = a; *(u32x2*)(vdst + nxt + 8) = b;
        *(u32x2*)(vdst + nxt + 64 * VRS) = c; *(u32x2*)(vdst + nxt + 64 * VRS + 8) = d;
      }
      __syncthreads();
    }
#undef ATT_QK
    float ssq = 0.f;
#pragma unroll
    for (int et = 0; et < 4; ++et)
#pragma unroll
      for (int i = 0; i < 16; ++i) ssq += o[et][i] * o[et][i];
    ssq += shx(ssq, 32);
    const float r = rsqrtf(ssq * (1.f / 128.f) + EPS) * (1.f - lam_init);
    bf16_t* op = O + (size_t)tq * 1024 + hp * 128 + 4 * half;
#pragma unroll
    for (int et = 0; et < 4; ++et)
#pragma unroll
      for (int qd = 0; qd < 4; ++qd) {
        const int e = 32 * et + 8 * qd;
        const f32x4 g4 = *(const f32x4*)(gsub + e + 4 * half);
        u32x2 ov = {pk2(o[et][4 * qd + 0] * r * g4.x, o[et][4 * qd + 1] * r * g4.y),
                    pk2(o[et][4 * qd + 2] * r * g4.z, o[et][4 * qd + 3] * r * g4.w)};
        *(u32x2*)(op + e) = ov;
      }
  }
  __syncthreads();
}

typedef __attribute__((address_space(4))) const Params* KParams;
DI KParams PP() {
  KParams k = (KParams)__builtin_amdgcn_kernarg_segment_ptr();
  asm volatile("" : "+s"(k));
  return k;
}
#define XB_TMO      128
#define XB_XCNT(j)  (256  + 64 * (j))
#define XB_XSUB(j)  (1280 + 64 * (j))
#define XB_XGEN(j)  (2304 + 64 * (j))
#define XB_TOP      3328
#define XB_TOPGEN   3392
#define XCD_BAR_WORDS 3456
#define XB_SPIN_CAP (1u << 18)
#define LAS __attribute__((address_space(3)))

__device__ __forceinline__ unsigned xb_ld(unsigned* p)              { return __hip_atomic_load(p, __ATOMIC_RELAXED, __HIP_MEMORY_SCOPE_AGENT); }
__device__ __forceinline__ unsigned xb_add(unsigned* p, unsigned v) { return __hip_atomic_fetch_add(p, v, __ATOMIC_RELAXED, __HIP_MEMORY_SCOPE_AGENT); }
__device__ __forceinline__ unsigned xb_xcc_id() { return (unsigned)__builtin_amdgcn_s_getreg((3 << 11) | 20) & 0xFu; }
#define XB_SPIN(cond, bar) do { unsigned _sp = 0; while (cond) { __builtin_amdgcn_s_sleep(1); \
    if ((++_sp & 255u) == 0u) { if (xb_ld(&(bar)[XB_TMO])) break; if (_sp > XB_SPIN_CAP) { atomicAdd(&(bar)[XB_TMO], 1u); break; } } } } while (0)

struct XcdBarrier {
    unsigned* bar; unsigned x;
    volatile LAS unsigned* st;
};

__device__ __forceinline__ XcdBarrier xcd_barrier_post(unsigned* bar, volatile LAS unsigned* st) {
    XcdBarrier b; b.bar = bar; b.x = xb_xcc_id(); b.st = st;
    if (threadIdx.x == 0) (void)xb_add(&bar[XB_XCNT(b.x)], 1u);
    return b;
}
__device__ __forceinline__ void xcd_barrier_complete(unsigned* bar, unsigned x, unsigned& nloc, unsigned& nx) {
    const unsigned G = gridDim.x * gridDim.y * gridDim.z;
    unsigned sum, cnt, mine, sp = 0u;
    for (;;) {
        sum = 0u; cnt = 0u; mine = 0u;
#pragma unroll
        for (unsigned j = 0; j < 16; ++j) { const unsigned c = xb_ld(&bar[XB_XCNT(j)]); sum += c; cnt += (c > 0u) ? 1u : 0u; mine = (j == x) ? c : mine; }
        if (sum == G) break;
        __builtin_amdgcn_s_sleep(1);
        if ((++sp & 255u) == 0u) { if (xb_ld(&bar[XB_TMO])) break; if (sp > XB_SPIN_CAP) { atomicAdd(&bar[XB_TMO], 1u); break; } }
    }
    nloc = mine > 0u ? mine : 1u; nx = cnt > 0u ? cnt : 1u;
}

__device__ __forceinline__ void xcd_barrier(const XcdBarrier& b) {
    asm volatile("s_waitcnt vmcnt(0)" ::: "memory");
    __syncthreads();
    if (threadIdx.x == 0) {
        unsigned* bar = b.bar;
        __builtin_amdgcn_s_waitcnt(0);
        unsigned nloc = b.st[0], nx = b.st[1];
        if (nloc == 0u) { xcd_barrier_complete(bar, b.x, nloc, nx); b.st[0] = nloc; b.st[1] = nx; }
        const unsigned old = xb_add(&bar[XB_XSUB(b.x)], 1u);
        const unsigned gen = old / nloc;
        if (old + 1u == (gen + 1u) * nloc) {
            __builtin_amdgcn_fence(__ATOMIC_RELEASE, "agent");
            asm volatile("s_waitcnt vmcnt(0)" ::: "memory");
            const unsigned og = xb_add(&bar[XB_TOP], 1u);
            const unsigned tg = og / nx;
            if (og + 1u == (tg + 1u) * nx) xb_add(&bar[XB_TOPGEN], 1u);
            else XB_SPIN(xb_ld(&bar[XB_TOPGEN]) == tg, bar);
            __builtin_amdgcn_fence(__ATOMIC_ACQUIRE, "agent");
            xb_add(&bar[XB_XGEN(b.x)], 1u);
            asm volatile("s_waitcnt vmcnt(0)" ::: "memory");
        } else {
            XB_SPIN(xb_ld(&bar[XB_XGEN(b.x)]) == gen, bar);
            __builtin_amdgcn_fence(__ATOMIC_ACQUIRE, "agent");
            asm volatile("s_waitcnt vmcnt(0)" ::: "memory");
        }
    }
    __syncthreads();
}

#define WSB() (PP()->ws)
#define MOD ((float*)(WSB() + OFF_MOD))
#define ROTC ((float*)(WSB() + OFF_ROT))
#define ROTS ((float*)(WSB() + OFF_ROT) + 2048 * 32)
#define RSTD ((float*)(WSB() + OFF_RSTD))
#define DT ((float*)(WSB() + OFF_DT))
#define ACST ((float*)(WSB() + OFF_ACST))
#define BST ((float*)(WSB() + OFF_BST))
#define WST ((float*)(WSB() + OFF_WST))
#define DEC ((float*)(WSB() + OFF_DEC))
#define WA ((bf16_t*)(WSB() + OFF_WA))
#define WB ((bf16_t*)(WSB() + OFF_WB))
#define WU ((bf16_t*)(WSB() + OFF_WU))
#define WD ((bf16_t*)(WSB() + OFF_WD))
#define H ((bf16_t*)(WSB() + OFF_H))
#define RA (WSB() + OFF_RA)
#define RB (WSB() + OFF_RB)
#define xo (PP()->out)
#define GSYNC() do { XcdBarrier b_; b_.bar = (unsigned*)(WSB() + OFF_BAR); b_.x = xb_xcc_id(); b_.st = (volatile LAS unsigned*)&xb_words; xcd_barrier(b_); } while (0)
#define CONVERT_MIXER(L_, F_, S_)                                                                                             \
  do {                                                                                                                        \
    const int k_ = (L_) % 3, j_ = (L_) / 3;                                                                                   \
    if (k_ == 0) {                                                                                                            \
      convert_wt(PP()->ssd_w_in + (size_t)j_ * 1024 * 6208, 1024, 6208, WA, nullptr, vsm, false, F_, S_);                     \
      convert_wt(PP()->ssd_w_out + (size_t)j_ * 2048 * 1024, 2048, 1024, WB, PP()->ssd_norm_g + j_ * 2048, vsm, false, F_, S_); \
    } else if (k_ == 1) {                                                                                                     \
      convert_wt(PP()->sc_w_in, 1024, 3072, WA, nullptr, vsm, false, F_, S_);                                                 \
      convert_wt(PP()->sc_w_out, 1024, 1024, WB, nullptr, vsm, false, F_, S_);                                                \
    } else {                                                                                                                  \
      convert_wt(PP()->da_w_qkv, 1024, 3072, WA, nullptr, vsm, false, F_, S_);                                                \
      convert_wt(PP()->da_w_out, 1024, 1024, WB, nullptr, vsm, false, F_, S_);                                                \
    }                                                                                                                         \
  } while (0)
#define CONVERT_FFN(L_, F_, S_)                                                                                               \
  do {                                                                                                                        \
    convert_wt(PP()->ffn_w_up + (size_t)(L_) * 1024 * 5632, 1024, 5632, WU, nullptr, vsm, true, F_, S_);                      \
    convert_wt(PP()->ffn_w_down + (size_t)(L_) * 2816 * 1024, 2816, 1024, WD, nullptr, vsm, false, F_, S_);                   \
  } while (0)
#define TAIL_IDLE(NTN_) ((((NTN_) * 8) & 31) != 0 && ((obid() >> 4) >= (((NTN_) * 8) & 31)))
#define TAIL_FIRST(NTN_) ((((obid() >> 4) - (((NTN_) * 8) & 31)) * 8 + ((obid() >> 1) & 7)) * 2 + (obid() & 1))
#define TAIL_STRIDE(NTN_) ((32 - (((NTN_) * 8) & 31)) * 16)
__global__ void __launch_bounds__(512) mega(Params p) {
  __shared__ __attribute__((aligned(16))) char smem[131072];
  char* vsm = smem + (threadIdx.x >> 8) * 65536;
  cg::grid_group grid = cg::this_grid();

  __shared__ u32x4 xb_words;
  if (threadIdx.x == 0) { u32x4 z = {0u, 0u, 0u, 0u}; xb_words = z; }
  __syncthreads();
  (void)xcd_barrier_post((unsigned*)(WSB() + OFF_BAR), (volatile LAS unsigned*)&xb_words);
  mod_phase(PP()->c_ctx, PP()->c, PP()->w_mod, PP()->b_mod, MOD, vsm);
  rot_phase(ROTC, ROTS);
  CONVERT_MIXER(0, -1, 0);
  if (__builtin_expect(gridDim.y == 0x7fffu, 0)) grid.sync();
  GSYNC();

  for (int l = 0; l < 4; ++l) {
    const int kind = l % 3, j = l / 3;
    const float* modl = MOD + (size_t)l * 5 * 6144;
    if (kind != 0) CONVERT_FFN(l, -1, 0);
    if (l == 0)
      row_phase(PP()->x_prompt, PP()->x_sample, nullptr, nullptr, nullptr, xo, H, PP()->norm_g + (l * 4 + 0) * 1024, modl + 0, modl + 1024);
    else
      row_phase(xo, xo + (size_t)TP * D, (const bf16_t*)RA, MOD + (size_t)(l - 1) * 5 * 6144 + 5120, PP()->norm_g + ((l - 1) * 4 + 3) * 1024,
                xo, H, PP()->norm_g + (l * 4 + 0) * 1024, modl + 0, modl + 1024);
    GSYNC();

    bf16_t* Mx = (bf16_t*)RB;
    if (kind == 0) {
      bf16_t* Z = (bf16_t*)RA;
      bf16_t* XBC = (bf16_t*)(RA + (size_t)T * 2048 * 2);
      bf16_t* S = XBC;
      bf16_t* XT = (bf16_t*)RB;
      bf16_t* Bm = (bf16_t*)(RB + (size_t)T * 2048 * 2);
      bf16_t* Cm = (bf16_t*)(RB + (size_t)T * 2048 * 2 + (size_t)T * 1024 * 2);
      {
        EpiSsdIn2 epi{Z, XT, Bm, Cm, (bf16_t*)(WSB() + OFF_UE), DT, PP()->ssd_dt_bias + j * 64,
                      PP()->ssd_conv_w + (size_t)j * 3 * 4096, PP()->ssd_conv_b + (size_t)j * 4096};
        gemm_phase(H, 1024, WA, 1024, 25, epi, smem);
      }
      if (gridDim.x == 256) { if (TAIL_IDLE(25)) CONVERT_FFN(l, TAIL_FIRST(25), TAIL_STRIDE(25)); }
      else CONVERT_FFN(l, -1, 0);
      GSYNC();
      ssd_fix_phase((const bf16_t*)(WSB() + OFF_UE), PP()->ssd_conv_w + (size_t)j * 3 * 4096, PP()->ssd_conv_b + (size_t)j * 4096, XT, Bm, Cm);
      ssd_cumsum_phase(DT, PP()->ssd_a_log + j * 64, ACST, BST, WST, DEC);
      GSYNC();
      ssd_states_phase(XT, Bm, WST, S, vsm);
      GSYNC();
      ssd_scan_phase(S, DEC, PP()->state_ssm, j, xo + OUT_STATE);
      GSYNC();
      ssd_y_phase(XT, Bm, Cm, S, ACST, BST, PP()->ssd_d + j * 32, Z, vsm);
      GSYNC();
      ssq_phase(Z, RSTD);
      GSYNC();
      {
        EpiBF16 epi{Mx, 1024, RSTD};
        gemm_phase(Z, 2048, WB, 2048, 4, epi, smem);
      }
      GSYNC();
    } else if (kind == 1) {
      bf16_t* BCU = (bf16_t*)RA;
      {
        EpiBF16 epi{BCU, 3072, nullptr};
        gemm_phase(H, 1024, WA, 1024, 12, epi, smem);
      }
      GSYNC();
      sc_mid_phase(BCU, PP()->sc_conv_w, H);
      GSYNC();
      {
        EpiBF16 epi{Mx, 1024, nullptr};
        gemm_phase(H, 1024, WB, 1024, 4, epi, smem);
      }
      GSYNC();
    } else {
      bf16_t* Q = (bf16_t*)RA;
      bf16_t* KB = (bf16_t*)(RA + (size_t)T * 1024 * 2);
      bf16_t* VT = (bf16_t*)(RA + (size_t)T * 1024 * 2 + (size_t)17408 * 1024 * 2);
      const float lam_init = 0.8f - 0.6f * __expf(-0.3f * (float)l);
      float d01 = 0.f, d23 = 0.f;
      for (int i = 0; i < 64; ++i) { d01 += PP()->da_lambda[i] * PP()->da_lambda[64 + i]; d23 += PP()->da_lambda[128 + i] * PP()->da_lambda[192 + i]; }
      const float lam = __expf(d01) - __expf(d23) + lam_init;
      cache_phase(PP()->cache_k, PP()->cache_v, KB, VT);
      {
        EpiQKV epi{Q, KB, VT, xo + OUT_CK, xo + OUT_CV, ROTC, ROTS};
        gemm_phase(H, 1024, WA, 1024, 12, epi, smem);
      }
      GSYNC();
      attn_phase(Q, KB, VT, H, PP()->da_subln_g, lam, lam_init, vsm);
      GSYNC();
      {
        EpiBF16 epi{Mx, 1024, nullptr};
        gemm_phase(H, 1024, WB, 1024, 4, epi, smem);
      }
      GSYNC();
    }
    row_phase(xo, xo + (size_t)TP * D, Mx, modl + 2048, PP()->norm_g + (l * 4 + 1) * 1024, xo, H, PP()->norm_g + (l * 4 + 2) * 1024, modl + 3072, modl + 4096);
    GSYNC();
    {
      EpiGate epi{(bf16_t*)RB, (bf16_t*)(WSB() + OFF_UE), PP()->ffn_conv_w + (size_t)l * 3 * 5632};
      gemm_phase(H, 1024, WU, 1024, 22, epi, smem);
    }
    if (l < 3) {
      if (gridDim.x == 256) { if (TAIL_IDLE(22)) CONVERT_MIXER(l + 1, TAIL_FIRST(22), TAIL_STRIDE(22)); }
      else CONVERT_MIXER(l + 1, -1, 0);
    }
    GSYNC();
    ffn_fix_phase((const bf16_t*)(WSB() + OFF_UE), PP()->ffn_conv_w + (size_t)l * 3 * 5632, (bf16_t*)RB);
    GSYNC();
    {
      EpiBF16 epi{(bf16_t*)RA, 1024, nullptr};
      gemm_phase((const bf16_t*)RB, 2816, WD, 2816, 4, epi, smem);
    }
    GSYNC();
  }
  row_phase(xo, xo + (size_t)TP * D, (const bf16_t*)RA, MOD + (size_t)3 * 5 * 6144 + 5120, PP()->norm_g + (3 * 4 + 3) * 1024,
            xo, nullptr, nullptr, nullptr, nullptr);
}

#undef MOD
#undef ROTC
#undef ROTS
#undef RSTD
#undef DT
#undef ACST
#undef BST
#undef WST
#undef DEC
#undef WA
#undef WB
#undef WU
#undef WD
#undef H
#undef RA
#undef RB
#undef xo
extern "C" void kernel_launch(void* const* d_in, const int* in_sizes, int n_in, void* d_out, int out_size, void* d_ws, size_t ws_size,
                              hipStream_t stream) {
  if (ws_size < WS_NEED) { fprintf(stderr, "workspace too small: %zu < %zu\n", ws_size, (size_t)WS_NEED); return; }
  static int grid_blocks = 0;
  if (!grid_blocks) {
    int dev = 0, cus = 0, per_cu = 0;
    hipGetDevice(&dev);
    hipDeviceGetAttribute(&cus, hipDeviceAttributeMultiprocessorCount, dev);
    hipOccupancyMaxActiveBlocksPerMultiprocessor(&per_cu, mega, 512, 0);
    if (per_cu > 1) per_cu = 1;
    grid_blocks = cus * per_cu;
  }
  Params p{};
  const float** pp = (const float**)&p;
  for (int i = 0; i < 28; ++i) pp[i] = (const float*)d_in[i];
  p.out = (float*)d_out;
  p.ws = (char*)d_ws;
  hipMemsetAsync((char*)d_ws + OFF_BAR, 0, (size_t)XCD_BAR_WORDS * 4, stream);
  void* args[] = {&p};
  hipError_t e = hipLaunchCooperativeKernel((void*)mega, dim3(grid_blocks), dim3(512), args, 0, stream);
  if (e != hipSuccess) fprintf(stderr, "cooperative launch failed: %s (grid %d)\n", hipGetErrorString(e), grid_blocks);
}
```

```cpp
#include <hip/hip_runtime.h>
#include <hip/hip_cooperative_groups.h>
#include <cstdio>
namespace cg = cooperative_groups;

#define DI __device__ __forceinline__
typedef unsigned short bf16_t;
using bf16x8 = __attribute__((ext_vector_type(8))) short;
using f32x16 = __attribute__((ext_vector_type(16))) float;
typedef __bf16 bf2_t __attribute__((ext_vector_type(2)));
typedef float f2_t __attribute__((ext_vector_type(2)));
typedef unsigned u32x4 __attribute__((ext_vector_type(4)));
typedef unsigned u32x2 __attribute__((ext_vector_type(2)));
typedef float f32x4 __attribute__((ext_vector_type(4)));
#define MFMA(a, b, c) __builtin_amdgcn_mfma_f32_32x32x16_bf16((a), (b), (c), 0, 0, 0)

constexpr int T = 16384, TP = 8192, D = 1024;
constexpr float EPS = 1e-6f;

constexpr size_t al256(size_t x) { return (x + 255) & ~(size_t)255; }
constexpr size_t OFF_MOD = 0;
constexpr size_t OFF_ROT = al256(OFF_MOD + (size_t)4 * 5 * 6144 * 4);
constexpr size_t OFF_RSTD = al256(OFF_ROT + (size_t)2 * 2048 * 32 * 4);
constexpr size_t OFF_DT = al256(OFF_RSTD + (size_t)T * 4);
constexpr size_t OFF_ACST = al256(OFF_DT + (size_t)T * 64 * 4);
constexpr size_t OFF_BST = al256(OFF_ACST + (size_t)128 * 64 * 128 * 4);
constexpr size_t OFF_WST = al256(OFF_BST + (size_t)128 * 64 * 128 * 4);
constexpr size_t OFF_DEC = al256(OFF_WST + (size_t)128 * 64 * 128 * 4);
constexpr size_t OFF_WA = al256(OFF_DEC + (size_t)128 * 64 * 4);
constexpr size_t OFF_WB = al256(OFF_WA + (size_t)6400 * 1024 * 2);
constexpr size_t OFF_WU = al256(OFF_WB + (size_t)1024 * 2048 * 2);
constexpr size_t OFF_WD = al256(OFF_WU + (size_t)5632 * 1024 * 2);
constexpr size_t OFF_H = al256(OFF_WD + (size_t)1024 * 2816 * 2);
constexpr size_t OFF_RA = al256(OFF_H + (size_t)T * 1024 * 2);
constexpr size_t OFF_RB = al256(OFF_RA + (size_t)201326592);
constexpr size_t OFF_BAR = al256(OFF_RB + (size_t)134217728);
constexpr size_t OFF_UE = al256(OFF_BAR + (size_t)3456 * 4);
constexpr size_t WS_NEED = OFF_UE + (size_t)128 * 4 * 5632 * 2;

constexpr size_t OUT_STATE = (size_t)2 * TP * D;
constexpr size_t OUT_CK = OUT_STATE + (size_t)33554432;
constexpr size_t OUT_CV = OUT_CK + (size_t)8388608;

struct Params {
  const float *x_prompt, *x_sample, *state_ssm, *cache_k, *cache_v, *c, *c_ctx, *w_mod, *b_mod, *norm_g;
  const float *ssd_w_in, *ssd_conv_w, *ssd_conv_b, *ssd_dt_bias, *ssd_a_log, *ssd_d, *ssd_norm_g, *ssd_w_out;
  const float *sc_w_in, *sc_conv_w, *sc_w_out, *da_w_qkv, *da_lambda, *da_subln_g, *da_w_out;
  const float *ffn_w_up, *ffn_conv_w, *ffn_w_down;
  float* out;
  char* ws;
};

DI float bf2f(bf16_t v) { return __uint_as_float(((unsigned)v) << 16); }
DI unsigned pk2(float a, float b) { f2_t v = {a, b}; bf2_t r = __builtin_convertvector(v, bf2_t); return __builtin_bit_cast(unsigned, r); }
DI bf16_t f2bf(float a) { return (bf16_t)(pk2(a, 0.f) & 0xffffu); }
DI float lo_f(unsigned u) { return __uint_as_float(u << 16); }
DI float hi_f(unsigned u) { return __uint_as_float(u & 0xffff0000u); }
DI bf16x8 ld8(const bf16_t* p) { return *(const bf16x8*)p; }
DI bf16x8 ld4x2(const bf16_t* p0, const bf16_t* p1) {
  u32x2 a = *(const u32x2*)p0, b = *(const u32x2*)p1;
  u32x4 v = {a.x, a.y, b.x, b.y};
  return __builtin_bit_cast(bf16x8, v);
}
DI bf16x8 pack8(float a0, float a1, float a2, float a3, float a4, float a5, float a6, float a7) {
  u32x4 v = {pk2(a0, a1), pk2(a2, a3), pk2(a4, a5), pk2(a6, a7)};
  return __builtin_bit_cast(bf16x8, v);
}
DI float shx(float v, int mask) {
  int lane = __builtin_amdgcn_mbcnt_hi(-1, __builtin_amdgcn_mbcnt_lo(-1, 0));
  asm volatile("" : "+v"(lane));
  return __builtin_bit_cast(float, __builtin_amdgcn_ds_bpermute((lane ^ mask) << 2, __builtin_bit_cast(int, v)));
}
DI float wave_sum(float v) {
#pragma unroll
  for (int o = 32; o > 0; o >>= 1) v += shx(v, o);
  return v;
}
DI float silu(float x) { return x / (1.f + __expf(-x)); }
DI void zero16(f32x16& a) {
#pragma unroll
  for (int i = 0; i < 16; ++i) a[i] = 0.f;
}
DI int crow(int i, int half) { return (i & 3) + 8 * (i >> 2) + 4 * half; }
DI int otid() { int t = threadIdx.x & 255; asm volatile("" : "+v"(t)); return t; }
DI int obid() { int b = blockIdx.x * 2 + (threadIdx.x >> 8); asm volatile("" : "+v"(b)); return __builtin_amdgcn_readfirstlane(b); }
#define VGRID (gridDim.x * 2)

DI void mod_phase(const float* c_ctx, const float* c_in, const float* w_mod, const float* b_mod, float* MOD, char* smem) {
  float* s = (float*)smem;
  float* red = s + 5 * 1024;
  const int tid = otid();
  for (int it = obid(); it < 4 * 96; it += VGRID) {
    const int l = it / 96, n0 = (it % 96) * 64;
    __syncthreads();
    for (int i = tid; i < 5 * 1024; i += 256) {
      const int c = i >> 10, k = i & 1023;
      const float v = (c == 0) ? c_ctx[k] : c_in[(c - 1) * 1024 + k];
      s[i] = silu(v);
    }
    __syncthreads();
    const int cg = tid & 15, kg = tid >> 4;
    const float* w = w_mod + ((size_t)l * 1024 + kg * 64) * 6144 + n0 + 4 * cg;
    f32x4 a0 = {0.f, 0.f, 0.f, 0.f}, a1 = a0, a2 = a0, a3 = a0, a4 = a0;
#pragma unroll 8
    for (int k = 0; k < 64; ++k) {
      const f32x4 wv = __builtin_nontemporal_load((const f32x4*)(w + (size_t)k * 6144));
      const int kk = kg * 64 + k;
      a0 += s[kk] * wv; a1 += s[1024 + kk] * wv; a2 += s[2048 + kk] * wv; a3 += s[3072 + kk] * wv; a4 += s[4096 + kk] * wv;
    }
    *(f32x4*)(red + (kg * 5 + 0) * 64 + 4 * cg) = a0; *(f32x4*)(red + (kg * 5 + 1) * 64 + 4 * cg) = a1;
    *(f32x4*)(red + (kg * 5 + 2) * 64 + 4 * cg) = a2; *(f32x4*)(red + (kg * 5 + 3) * 64 + 4 * cg) = a3;
    *(f32x4*)(red + (kg * 5 + 4) * 64 + 4 * cg) = a4;
    __syncthreads();
    for (int i = tid; i < 320; i += 256) {
      const int c = i >> 6, cc = i & 63;
      float v = b_mod[l * 6144 + n0 + cc];
#pragma unroll
      for (int g = 0; g < 16; ++g) v += red[(g * 5 + c) * 64 + cc];
      MOD[(size_t)(l * 5 + c) * 6144 + n0 + cc] = v;
    }
  }
}

DI void rot_phase(float* ROTC, float* ROTS) {
  for (int i = obid() * 256 + otid(); i < 2048 * 32; i += VGRID * 256) {
    const int pos = i >> 5, k = i & 31;
    const float inv = powf(10000.f, -(float)(k & 15) / 16.f);
    const float base = (k < 16) ? (float)(pos >> 6) : (float)(pos & 63);
    const float ang = base * inv;
    ROTC[i] = cosf(ang);
    ROTS[i] = sinf(ang);
  }
}

DI int ffn_perm_row(int n) { return n < 2816 ? ((n >> 5) * 64 + (n & 31)) : (((n - 2816) >> 5) * 64 + 32 + ((n - 2816) & 31)); }
DI void convert_wt(const float* __restrict__ src, int K, int N, bf16_t* __restrict__ dst, const float* __restrict__ kscale, char* smem, bool perm = false, int first = -1, int stride = 0) {
  float* tile = (float*)smem;
  const int tid = otid();
  const int tk = K >> 6, tn = N >> 6;
  if (first < 0) { first = obid(); stride = VGRID; }
  for (int it = first; it < tk * tn; it += stride) {
    const int k0 = (it % tk) << 6, n0 = (it / tk) << 6;
    __syncthreads();
#pragma unroll
    for (int ps = 0; ps < 4; ++ps) {
      const int k = (tid >> 4) + 16 * ps, n4 = (tid & 15) * 4;
      const f32x4 v = __builtin_nontemporal_load((const f32x4*)(src + (size_t)(k0 + k) * N + n0 + n4));
      const float sc = kscale ? kscale[k0 + k] : 1.f;
      tile[k * 65 + n4 + 0] = v.x * sc; tile[k * 65 + n4 + 1] = v.y * sc;
      tile[k * 65 + n4 + 2] = v.z * sc; tile[k * 65 + n4 + 3] = v.w * sc;
    }
    __syncthreads();
    const int n = tid >> 2, ks = (tid & 3) * 16;
    unsigned q[8];
#pragma unroll
    for (int j = 0; j < 8; ++j) q[j] = pk2(tile[(ks + 2 * j) * 65 + n], tile[(ks + 2 * j + 1) * 65 + n]);
    const int nrow = perm ? ffn_perm_row(n0 + n) : n0 + n;
    u32x4* d = (u32x4*)(dst + (size_t)nrow * K + k0 + ks);
    u32x4 v0 = {q[0], q[1], q[2], q[3]}, v1 = {q[4], q[5], q[6], q[7]};
    d[0] = v0; d[1] = v1;
  }
}

DI void row_phase(const float* __restrict__ xin_p, const float* __restrict__ xin_s, const bf16_t* __restrict__ f, const float* __restrict__ gate,
                  const float* __restrict__ gprev, float* xout, bf16_t* __restrict__ hout, const float* __restrict__ gn,
                  const float* __restrict__ sh, const float* __restrict__ sc) {
  const int lane = otid() & 63;
  const int wid = obid() * 4 + (otid() >> 6), nw = VGRID * 4;
  for (int t0 = wid * 2; t0 < T; t0 += nw * 2) {
    const int mrow = t0 < TP ? 0 : 1 + ((t0 - TP) >> 11);
    const float* xr = (t0 < TP) ? xin_p + (size_t)t0 * D : xin_s + (size_t)(t0 - TP) * D;
    f32x4 xv[2][4], fv[2][4], gt[4], gp[4], g[4], s1[4], s0[4];
#pragma unroll
    for (int r = 0; r < 2; ++r)
#pragma unroll
      for (int j = 0; j < 4; ++j) xv[r][j] = *(const f32x4*)(xr + (size_t)r * D + lane * 4 + 256 * j);
    if (f) {
#pragma unroll
      for (int r = 0; r < 2; ++r)
#pragma unroll
        for (int j = 0; j < 4; ++j) {
          const u32x2 fr = *(const u32x2*)(f + (size_t)(t0 + r) * D + lane * 4 + 256 * j);
          f32x4 fx = {lo_f(fr.x), hi_f(fr.x), lo_f(fr.y), hi_f(fr.y)};
          fv[r][j] = fx;
        }
#pragma unroll
      for (int j = 0; j < 4; ++j) {
        gt[j] = *(const f32x4*)(gate + (size_t)mrow * 6144 + lane * 4 + 256 * j);
        gp[j] = *(const f32x4*)(gprev + lane * 4 + 256 * j);
      }
    }
    if (hout) {
#pragma unroll
      for (int j = 0; j < 4; ++j) {
        g[j] = *(const f32x4*)(gn + lane * 4 + 256 * j);
        s1[j] = *(const f32x4*)(sc + (size_t)mrow * 6144 + lane * 4 + 256 * j);
        s0[j] = *(const f32x4*)(sh + (size_t)mrow * 6144 + lane * 4 + 256 * j);
      }
    }
    if (f) {
      float q0 = 0.f, q1 = 0.f;
#pragma unroll
      for (int j = 0; j < 4; ++j) {
        q0 += fv[0][j].x * fv[0][j].x + fv[0][j].y * fv[0][j].y + fv[0][j].z * fv[0][j].z + fv[0][j].w * fv[0][j].w;
        q1 += fv[1][j].x * fv[1][j].x + fv[1][j].y * fv[1][j].y + fv[1][j].z * fv[1][j].z + fv[1][j].w * fv[1][j].w;
      }
      q0 = wave_sum(q0); q1 = wave_sum(q1);
      const float r0 = rsqrtf(q0 * (1.f / 1024.f) + EPS), r1 = rsqrtf(q1 * (1.f / 1024.f) + EPS);
#pragma unroll
      for (int j = 0; j < 4; ++j) {
        xv[0][j] += gt[j] * (fv[0][j] * r0 * gp[j]);
        xv[1][j] += gt[j] * (fv[1][j] * r1 * gp[j]);
      }
    }
#pragma unroll
    for (int r = 0; r < 2; ++r)
#pragma unroll
      for (int j = 0; j < 4; ++j) *(f32x4*)(xout + (size_t)(t0 + r) * D + lane * 4 + 256 * j) = xv[r][j];
    if (hout) {
      float q0 = 0.f, q1 = 0.f;
#pragma unroll
      for (int j = 0; j < 4; ++j) {
        q0 += xv[0][j].x * xv[0][j].x + xv[0][j].y * xv[0][j].y + xv[0][j].z * xv[0][j].z + xv[0][j].w * xv[0][j].w;
        q1 += xv[1][j].x * xv[1][j].x + xv[1][j].y * xv[1][j].y + xv[1][j].z * xv[1][j].z + xv[1][j].w * xv[1][j].w;
      }
      q0 = wave_sum(q0); q1 = wave_sum(q1);
      const float rr[2] = {rsqrtf(q0 * (1.f / 1024.f) + EPS), rsqrtf(q1 * (1.f / 1024.f) + EPS)};
#pragma unroll
      for (int r = 0; r < 2; ++r)
#pragma unroll
        for (int j = 0; j < 4; ++j) {
          const f32x4 hv = xv[r][j] * rr[r] * g[j] * (1.f + s1[j]) + s0[j];
          u32x2 o = {pk2(hv.x, hv.y), pk2(hv.z, hv.w)};
          *(u32x2*)(hout + (size_t)(t0 + r) * D + lane * 4 + 256 * j) = o;
        }
    }
  }
}

constexpr int GM = 4;
#define LAS3 __attribute__((address_space(3)))
constexpr int GSTG = 32768;
DI void glds16(const void* gsrc, unsigned lds_dst_uniform) {
  asm volatile("s_mov_b32 m0, %1\n\ts_nop 0\n\tglobal_load_lds_dwordx4 %0, off"
               : : "v"(gsrc), "s"(lds_dst_uniform) : "memory", "m0");
}
template <class Epi>
DI void gemm_phase(const bf16_t* __restrict__ A, int lda, const bf16_t* __restrict__ Bt, int K, int ntn, const Epi& epi, char* smem) {
  int tid = threadIdx.x;
  asm volatile("" : "+v"(tid));
  const int lane = tid & 63, wave = tid >> 6;
  const int wm = (wave >> 2) * 128, wn = (wave & 3) * 64;
  const int l31 = lane & 31, half = lane >> 5;
  const int grow = tid >> 2;
  const int gch = ((tid & 3) ^ ((tid >> 4) & 3)) * 8;
  const int sw = (l31 >> 2) & 3;
  LAS3 char* sm3 = (LAS3 char*)smem;
  const unsigned sbase = (unsigned)(size_t)smem;
  const int offA0 = (wm + l31) * 64 + ((half ^ sw) * 16);
  const int offA1 = (wm + l31) * 64 + (((2 + half) ^ sw) * 16);
  const int offB0 = 16384 + (wn + l31) * 64 + ((half ^ sw) * 16);
  const int offB1 = 16384 + (wn + l31) * 64 + (((2 + half) ^ sw) * 16);
  const int nk = K >> 5;
  int bid = blockIdx.x;
  asm volatile("" : "+v"(bid));
  bid = __builtin_amdgcn_readfirstlane(bid);
  const int xcd = bid & 7, gpx = gridDim.x >> 3;
  for (int idx = bid >> 3; idx < ntn * 8; idx += gpx) {
    const int tm = xcd * 8 + (idx & 7), tn = idx >> 3;
    const bf16_t* Ag = A + (size_t)(tm * 256 + grow) * lda + gch;
    const bf16_t* Bg = Bt + (size_t)(tn * 256 + grow) * K + gch;
    f32x16 acc[GM][2];
#pragma unroll
    for (int i = 0; i < GM; ++i)
#pragma unroll
      for (int j = 0; j < 2; ++j) zero16(acc[i][j]);
#define GISSUE(kt_, stg_)                                                                                         \
    do {                                                                                                          \
      const unsigned d_ = __builtin_amdgcn_readfirstlane(sbase + (stg_) * GSTG + wave * 1024);                    \
      glds16(Ag + (kt_) * 32, d_);                                                                                \
      glds16(Ag + (size_t)128 * lda + (kt_) * 32, d_ + 8192);                                                     \
      glds16(Bg + (kt_) * 32, d_ + 16384);                                                                        \
      glds16(Bg + (size_t)128 * K + (kt_) * 32, d_ + 16384 + 8192);                                               \
    } while (0)
    asm volatile("s_waitcnt vmcnt(0) lgkmcnt(0)" ::: "memory");
    __builtin_amdgcn_s_barrier();
    asm volatile("" ::: "memory");
    GISSUE(0, 0);
    GISSUE(1, 1);
    GISSUE(2, 2);
    bf16x8 pb[2], pa[GM];
    {
      const bf16x8 z8 = {0, 0, 0, 0, 0, 0, 0, 0};
      pb[0] = z8; pb[1] = z8;
#pragma unroll
      for (int mt = 0; mt < GM; ++mt) pa[mt] = z8;
    }
    for (int kt = 0; kt < nk; ++kt) {
      if (kt + 2 < nk) asm volatile("s_waitcnt vmcnt(8) lgkmcnt(0)" ::: "memory");
      else if (kt + 1 < nk) asm volatile("s_waitcnt vmcnt(4) lgkmcnt(0)" ::: "memory");
      else asm volatile("s_waitcnt vmcnt(0) lgkmcnt(0)" ::: "memory");
      __builtin_amdgcn_s_barrier();
      asm volatile("" ::: "memory");
      const int stg = kt & 3, stg3 = (kt + 3) & 3;
      const bool pre = kt + 3 < nk;
      const unsigned gd = __builtin_amdgcn_readfirstlane(sbase + stg3 * GSTG + wave * 1024);
      const bf16_t* Agk = Ag + (kt + 3) * 32;
      const bf16_t* Bgk = Bg + (kt + 3) * 32;
      const LAS3 char* st = sm3 + stg * GSTG;
      bf16x8 fb0[2], fa0[GM];
      fb0[0] = *(const LAS3 bf16x8*)(st + offB0);
      fb0[1] = *(const LAS3 bf16x8*)(st + offB0 + 32 * 64);
#pragma unroll
      for (int mt = 0; mt < GM; ++mt) fa0[mt] = *(const LAS3 bf16x8*)(st + offA0 + mt * 32 * 64);
      if (pre) glds16(Agk, gd);
      __builtin_amdgcn_sched_barrier(0);
#pragma unroll
      for (int mt = 0; mt < GM; ++mt) {
        acc[mt][0] = MFMA(pa[mt], pb[0], acc[mt][0]);
        acc[mt][1] = MFMA(pa[mt], pb[1], acc[mt][1]);
        if (mt == 1) { if (pre) glds16(Agk + (size_t)128 * lda, gd + 8192); __builtin_amdgcn_sched_barrier(0); }
      }
      __builtin_amdgcn_sched_barrier(0);
      pb[0] = *(const LAS3 bf16x8*)(st + offB1);
      pb[1] = *(const LAS3 bf16x8*)(st + offB1 + 32 * 64);
#pragma unroll
      for (int mt = 0; mt < GM; ++mt) pa[mt] = *(const LAS3 bf16x8*)(st + offA1 + mt * 32 * 64);
      __builtin_amdgcn_sched_barrier(0);
#pragma unroll
      for (int mt = 0; mt < GM; ++mt) {
        acc[mt][0] = MFMA(fa0[mt], fb0[0], acc[mt][0]);
        acc[mt][1] = MFMA(fa0[mt], fb0[1], acc[mt][1]);
        if (mt == 0) { if (pre) glds16(Bgk, gd + 16384); __builtin_amdgcn_sched_barrier(0); }
        if (mt == 2) { if (pre) glds16(Bgk + (size_t)128 * K, gd + 16384 + 8192); __builtin_amdgcn_sched_barrier(0); }
      }
    }
#pragma unroll
    for (int mt = 0; mt < GM; ++mt) {
      acc[mt][0] = MFMA(pa[mt], pb[0], acc[mt][0]);
      acc[mt][1] = MFMA(pa[mt], pb[1], acc[mt][1]);
    }
#undef GISSUE
    epi(acc, tm * 256 + wm, tn * 256 + wn, lane);
  }
  asm volatile("s_waitcnt vmcnt(0) lgkmcnt(0)" ::: "memory");
  __syncthreads();
}

struct EpiF32 {
  float* out; int ld; const float* rstd;
  DI void operator()(const f32x16 (&acc)[GM][2], int rbase, int cbase, int lane) const {
    const int l31 = lane & 31, half = lane >> 5;
#pragma unroll
    for (int mt = 0; mt < GM; ++mt)
#pragma unroll
      for (int i = 0; i < 16; ++i) {
        const int row = rbase + 32 * mt + crow(i, half);
        const float s = rstd ? rstd[row] : 1.f;
#pragma unroll
        for (int nt = 0; nt < 2; ++nt) out[(size_t)row * ld + cbase + 32 * nt + l31] = acc[mt][nt][i] * s;
      }
  }
};
struct EpiBF16 {
  bf16_t* out; int ld; const float* rstd;
  DI void operator()(const f32x16 (&acc)[GM][2], int rbase, int cbase, int lane) const {
    const int l31 = lane & 31, half = lane >> 5;
#pragma unroll
    for (int mt = 0; mt < GM; ++mt)
#pragma unroll
      for (int i = 0; i < 16; ++i) {
        const int row = rbase + 32 * mt + crow(i, half);
        const float s = rstd ? rstd[row] : 1.f;
#pragma unroll
        for (int nt = 0; nt < 2; ++nt) out[(size_t)row * ld + cbase + 32 * nt + l31] = f2bf(acc[mt][nt][i] * s);
      }
  }
};
struct EpiSsdIn {
  bf16_t* Z; bf16_t* XBC; float* DT; const float* dt_bias;
  DI void operator()(const f32x16 (&acc)[GM][2], int rbase, int cbase, int lane) const {
    const int l31 = lane & 31, half = lane >> 5;
    if (cbase >= 6208) return;
#pragma unroll
    for (int mt = 0; mt < GM; ++mt)
#pragma unroll
      for (int i = 0; i < 16; ++i) {
        const int row = rbase + 32 * mt + crow(i, half);
#pragma unroll
        for (int nt = 0; nt < 2; ++nt) {
          const int col = cbase + 32 * nt + l31;
          const float v = acc[mt][nt][i];
          if (cbase < 2048) Z[(size_t)row * 2048 + col] = f2bf(v);
          else if (cbase < 6144) XBC[(size_t)row * 4096 + col - 2048] = f2bf(v);
          else {
            const float x = v + dt_bias[col - 6144];
            const float u = __expf(-fabsf(x));
            const float lp = (u < 0.01f) ? u * (1.f - u * (0.5f - u * (1.f / 3.f))) : __logf(1.f + u);
            DT[(size_t)row * 64 + col - 6144] = fmaxf(x, 0.f) + lp;
          }
        }
      }
  }
};
constexpr float QSCALE = 0.125f * 1.4426950408889634f;
struct EpiQKV {
  bf16_t* Q; bf16_t* KB; bf16_t* VT; float* out_k; float* out_v; const float* ROTC; const float* ROTS;
  DI void operator()(const f32x16 (&acc)[GM][2], int rbase, int cbase, int lane) const {
    const int l31 = lane & 31, half = lane >> 5;
    const bool sample = rbase >= TP;
    if (cbase < 2048) {
      const bool isq = cbase < 1024;
#pragma unroll
      for (int mt = 0; mt < GM; ++mt)
#pragma unroll
        for (int i = 0; i < 16; ++i) {
          const int t = rbase + 32 * mt + crow(i, half);
          float x1 = acc[mt][0][i], x2 = acc[mt][1][i];
          int krow_ = t;
          if (sample) {
            const int pos = (t - TP) & 2047, b = (t - TP) >> 11;
            const float c = ROTC[pos * 32 + l31], s = ROTS[pos * 32 + l31];
            const float o1 = x1 * c - x2 * s, o2 = x2 * c + x1 * s;
            x1 = o1; x2 = o2;
            krow_ = TP + b * 2304 + 256 + pos;
          }
          if (isq) {
            Q[(size_t)t * 1024 + cbase + l31] = f2bf(x1 * QSCALE);
            Q[(size_t)t * 1024 + cbase + 32 + l31] = f2bf(x2 * QSCALE);
          } else {
            const int c0 = cbase - 1024;
            KB[(size_t)krow_ * 1024 + c0 + l31] = f2bf(x1);
            KB[(size_t)krow_ * 1024 + c0 + 32 + l31] = f2bf(x2);
            if (!sample) {
              __builtin_nontemporal_store(x1, out_k + (size_t)t * 1024 + c0 + l31);
              __builtin_nontemporal_store(x2, out_k + (size_t)t * 1024 + c0 + 32 + l31);
            }
          }
        }
    } else {
      const int c0 = cbase - 2048;
#pragma unroll
      for (int mt = 0; mt < GM; ++mt)
#pragma unroll
        for (int qd = 0; qd < 4; ++qd) {
          const int t = rbase + 32 * mt + 8 * qd + 4 * half;
          size_t vb; int L, key;
          if (sample) { const int b = (t - TP) >> 11; vb = (size_t)TP * 1024 + (size_t)b * 1024 * 2304; L = 2304; key = 256 + ((t - TP) & 2047); }
          else { const int s = t >> 8; vb = (size_t)s * 1024 * 256; L = 256; key = t & 255; }
#pragma unroll
          for (int nt = 0; nt < 2; ++nt) {
            const int c = c0 + 32 * nt + l31;
            const float v0 = acc[mt][nt][4 * qd + 0], v1 = acc[mt][nt][4 * qd + 1], v2 = acc[mt][nt][4 * qd + 2], v3 = acc[mt][nt][4 * qd + 3];
            u32x2 o = {pk2(v0, v1), pk2(v2, v3)};
            *(u32x2*)(VT + vb + (size_t)c * L + key) = o;
            if (!sample) {
              __builtin_nontemporal_store(v0, out_v + (size_t)(t + 0) * 1024 + c); __builtin_nontemporal_store(v1, out_v + (size_t)(t + 1) * 1024 + c);
              __builtin_nontemporal_store(v2, out_v + (size_t)(t + 2) * 1024 + c); __builtin_nontemporal_store(v3, out_v + (size_t)(t + 3) * 1024 + c);
            }
          }
        }
    }
  }
};

struct EpiGate {
  bf16_t* G; bf16_t* UE; const float* cw;
  DI void operator()(const f32x16 (&acc)[GM][2], int rbase, int cbase, int lane) const {
    const int l31 = lane & 31, half = lane >> 5;
    const int ch = (cbase >> 6) * 32 + l31;
    const float w0g = cw[ch], w1g = cw[5632 + ch], w2g = cw[11264 + ch];
    const float w0v = cw[2816 + ch], w1v = cw[5632 + 2816 + ch], w2v = cw[11264 + 2816 + ch];
    const int wt = rbase >> 7;
    {
      bf16_t* ue = UE + (size_t)wt * 4 * 5632 + cbase + l31;
      if (half == 0) {
        ue[0] = f2bf(acc[0][0][0]); ue[32] = f2bf(acc[0][1][0]);
        ue[5632] = f2bf(acc[0][0][1]); ue[5632 + 32] = f2bf(acc[0][1][1]);
      } else {
        ue[2 * 5632] = f2bf(acc[3][0][14]); ue[2 * 5632 + 32] = f2bf(acc[3][1][14]);
        ue[3 * 5632] = f2bf(acc[3][0][15]); ue[3 * 5632 + 32] = f2bf(acc[3][1][15]);
      }
    }
    bf16_t* gp = G + (size_t)(rbase + 4 * half) * 2816 + ch;
    float g3prev = 0.f, v3prev = 0.f, g0cur = shx(acc[0][0][0], 32), v0cur = shx(acc[0][1][0], 32);
#pragma unroll
    for (int mq = 0; mq < 16; ++mq) {
      const int mt = mq >> 2, q = mq & 3;
      const float g3cur = shx(acc[mt][0][4 * q + 3], 32), v3cur = shx(acc[mt][1][4 * q + 3], 32);
      const float g0next = (mq < 15) ? shx(acc[(mq + 1) >> 2][0][4 * ((mq + 1) & 3)], 32) : 0.f;
      const float v0next = (mq < 15) ? shx(acc[(mq + 1) >> 2][1][4 * ((mq + 1) & 3)], 32) : 0.f;
#pragma unroll
      for (int e = 0; e < 4; ++e) {
        float pg, pv, ng, nv;
        if (e > 0) { pg = acc[mt][0][4 * q + e - 1]; pv = acc[mt][1][4 * q + e - 1]; }
        else { pg = half ? g3cur : g3prev; pv = half ? v3cur : v3prev; }
        if (e < 3) { ng = acc[mt][0][4 * q + e + 1]; nv = acc[mt][1][4 * q + e + 1]; }
        else { ng = half ? g0next : g0cur; nv = half ? v0next : v0cur; }
        const float gg = w0g * pg + w1g * acc[mt][0][4 * q + e] + w2g * ng;
        const float vv = w0v * pv + w1v * acc[mt][1][4 * q + e] + w2v * nv;
        gp[(size_t)(32 * mt + 8 * q + e) * 2816] = f2bf(silu(gg) * vv);
      }
      g3prev = g3cur; v3prev = v3cur; g0cur = g0next; v0cur = v0next;
    }
  }
};

struct EpiSsdIn2 {
  bf16_t* Z; bf16_t* XT; bf16_t* Bm; bf16_t* Cm; bf16_t* UE; float* DT; const float* dt_bias; const float* cw; const float* cb;
  DI void operator()(const f32x16 (&acc)[GM][2], int rbase, int cbase, int lane) const {
    const int l31 = lane & 31, half = lane >> 5;
    if (cbase >= 6208) return;
    if (cbase < 2048) {
#pragma unroll
      for (int mt = 0; mt < GM; ++mt)
#pragma unroll
        for (int i = 0; i < 16; ++i) {
          const int row = rbase + 32 * mt + crow(i, half);
#pragma unroll
          for (int nt = 0; nt < 2; ++nt) Z[(size_t)row * 2048 + cbase + 32 * nt + l31] = f2bf(acc[mt][nt][i]);
        }
      return;
    }
    if (cbase >= 6144) {
#pragma unroll
      for (int mt = 0; mt < GM; ++mt)
#pragma unroll
        for (int i = 0; i < 16; ++i) {
          const int row = rbase + 32 * mt + crow(i, half);
#pragma unroll
          for (int nt = 0; nt < 2; ++nt) {
            const int col = cbase + 32 * nt + l31;
            const float x = acc[mt][nt][i] + dt_bias[col - 6144];
            const float u = __expf(-fabsf(x));
            const float lp = (u < 0.01f) ? u * (1.f - u * (0.5f - u * (1.f / 3.f))) : __logf(1.f + u);
            DT[(size_t)row * 64 + col - 6144] = fmaxf(x, 0.f) + lp;
          }
        }
      return;
    }
    const int chunk = rbase >> 7;
#pragma unroll
    for (int nt = 0; nt < 2; ++nt) {
      const int cc = cbase - 2048 + 32 * nt + l31;
      const float w0 = cw[cc], w1 = cw[4096 + cc], w2 = cw[8192 + cc], bb = cb[cc];
      {
        bf16_t* ue = UE + (size_t)chunk * 4 * 4096 + cc;
        if (half == 0) { ue[0] = f2bf(acc[0][nt][0]); ue[4096] = f2bf(acc[0][nt][1]); }
        else { ue[2 * 4096] = f2bf(acc[3][nt][14]); ue[3 * 4096] = f2bf(acc[3][nt][15]); }
      }
      float r3prev = 0.f, r0cur = shx(acc[0][nt][0], 32);
#pragma unroll
      for (int mq = 0; mq < 16; ++mq) {
        const int mt = mq >> 2, q = mq & 3;
        const float r3cur = shx(acc[mt][nt][4 * q + 3], 32);
        const float r0next = (mq < 15) ? shx(acc[(mq + 1) >> 2][nt][4 * ((mq + 1) & 3)], 32) : 0.f;
        float o[4];
#pragma unroll
        for (int e = 0; e < 4; ++e) {
          float pv, nv;
          if (e > 0) pv = acc[mt][nt][4 * q + e - 1];
          else pv = half ? r3cur : r3prev;
          if (e < 3) nv = acc[mt][nt][4 * q + e + 1];
          else nv = half ? r0next : r0cur;
          o[e] = silu(bb + w0 * pv + w1 * acc[mt][nt][4 * q + e] + w2 * nv);
        }
        r3prev = r3cur; r0cur = r0next;
        const int R0 = 32 * mt + 8 * q + 4 * half;
        if (cbase < 4096) {
          u32x2 v = {pk2(o[0], o[1]), pk2(o[2], o[3])};
          *(u32x2*)(XT + ((size_t)chunk * 2048 + cc) * 128 + R0) = v;
        } else {
          bf16_t* dst = (cbase < 5120) ? (Bm + (size_t)(rbase + R0) * 1024 + cc - 2048) : (Cm + (size_t)(rbase + R0) * 1024 + cc - 3072);
          dst[0] = f2bf(o[0]); dst[1024] = f2bf(o[1]); dst[2048] = f2bf(o[2]); dst[3072] = f2bf(o[3]);
        }
      }
    }
  }
};

DI bool has_prev(int t) { return t < TP ? (t & 255) != 0 : ((t - TP) & 2047) != 0; }
DI bool has_next(int t) { return t < TP ? (t & 255) != 255 : ((t - TP) & 2047) != 2047; }

DI void unpack8(const u32x4& v, float* o) {
  o[0] = lo_f(v.x); o[1] = hi_f(v.x); o[2] = lo_f(v.y); o[3] = hi_f(v.y);
  o[4] = lo_f(v.z); o[5] = hi_f(v.z); o[6] = lo_f(v.w); o[7] = hi_f(v.w);
}

DI void ssd_conv_phase(const bf16_t* __restrict__ XBC, const float* __restrict__ cw, const float* __restrict__ cb,
                       bf16_t* __restrict__ XT, bf16_t* __restrict__ Bm, bf16_t* __restrict__ Cm) {
  const int tid = otid();
  for (int it = obid(); it < 128 * 32; it += VGRID) {
    const int chunk = it >> 5, c = ((it & 31) << 6) + (tid & 63), sg = tid >> 6;
    const int t0 = chunk * 128 + sg * 32;
    const float w0 = cw[c], w1 = cw[4096 + c], w2 = cw[8192 + c], bb = cb[c];
    float prev = has_prev(t0) ? bf2f(XBC[(size_t)(t0 - 1) * 4096 + c]) : 0.f;
    float cur = bf2f(XBC[(size_t)t0 * 4096 + c]);
#pragma unroll
    for (int s8 = 0; s8 < 4; ++s8) {
      float o[8];
#pragma unroll
      for (int j = 0; j < 8; ++j) {
        const int t = t0 + s8 * 8 + j;
        const float nxt = has_next(t) ? bf2f(XBC[(size_t)(t + 1) * 4096 + c]) : 0.f;
        o[j] = silu(bb + w0 * prev + w1 * cur + w2 * nxt);
        prev = cur; cur = nxt;
      }
      u32x4 v = {pk2(o[0], o[1]), pk2(o[2], o[3]), pk2(o[4], o[5]), pk2(o[6], o[7])};
      *(u32x4*)(XT + ((size_t)chunk * 2048 + c) * 128 + sg * 32 + s8 * 8) = v;
    }
  }
  for (int i = obid() * 256 + tid; i < (T / 4) * 256; i += VGRID * 256) {
    const int t0 = (i >> 8) * 4, c8 = (i & 255) * 8;
    const int c = 2048 + c8;
    const bool hp = has_prev(t0), hn = has_next(t0 + 3);
    const u32x4 zero4 = {0u, 0u, 0u, 0u};
    u32x4 rr[6];
#pragma unroll
    for (int r = 0; r < 6; ++r) {
      const bool valid = (r == 0) ? hp : (r == 5) ? hn : true;
      rr[r] = valid ? *(const u32x4*)(XBC + (size_t)(t0 - 1 + r) * 4096 + c) : zero4;
    }
    float w0[8], w1[8], w2[8], bb[8];
    {
      const f32x4 a0 = *(const f32x4*)(cw + c), a1 = *(const f32x4*)(cw + c + 4);
      const f32x4 b0 = *(const f32x4*)(cw + 4096 + c), b1 = *(const f32x4*)(cw + 4096 + c + 4);
      const f32x4 c0 = *(const f32x4*)(cw + 8192 + c), c1 = *(const f32x4*)(cw + 8192 + c + 4);
      const f32x4 d0 = *(const f32x4*)(cb + c), d1 = *(const f32x4*)(cb + c + 4);
      w0[0] = a0.x; w0[1] = a0.y; w0[2] = a0.z; w0[3] = a0.w; w0[4] = a1.x; w0[5] = a1.y; w0[6] = a1.z; w0[7] = a1.w;
      w1[0] = b0.x; w1[1] = b0.y; w1[2] = b0.z; w1[3] = b0.w; w1[4] = b1.x; w1[5] = b1.y; w1[6] = b1.z; w1[7] = b1.w;
      w2[0] = c0.x; w2[1] = c0.y; w2[2] = c0.z; w2[3] = c0.w; w2[4] = c1.x; w2[5] = c1.y; w2[6] = c1.z; w2[7] = c1.w;
      bb[0] = d0.x; bb[1] = d0.y; bb[2] = d0.z; bb[3] = d0.w; bb[4] = d1.x; bb[5] = d1.y; bb[6] = d1.z; bb[7] = d1.w;
    }
#pragma unroll
    for (int k = 0; k < 4; ++k) {
      float xp[8], xc[8], xn[8], o[8];
      unpack8(rr[k], xp); unpack8(rr[k + 1], xc); unpack8(rr[k + 2], xn);
#pragma unroll
      for (int j = 0; j < 8; ++j) o[j] = silu(bb[j] + w0[j] * xp[j] + w1[j] * xc[j] + w2[j] * xn[j]);
      u32x4 v = {pk2(o[0], o[1]), pk2(o[2], o[3]), pk2(o[4], o[5]), pk2(o[6], o[7])};
      if (c8 < 1024) *(u32x4*)(Bm + (size_t)(t0 + k) * 1024 + c8) = v;
      else *(u32x4*)(Cm + (size_t)(t0 + k) * 1024 + c8 - 1024) = v;
    }
  }
}

DI void ssd_fix_phase(const bf16_t* __restrict__ UE, const float* __restrict__ cw, const float* __restrict__ cb,
                      bf16_t* __restrict__ XT, bf16_t* __restrict__ Bm, bf16_t* __restrict__ Cm) {
  for (int i = obid() * 256 + otid(); i < 128 * 2 * 512; i += VGRID * 256) {
    const int cc = (i & 511) * 8, k = (i >> 9) & 1, chunk = i >> 10;
    const int s = k ? 127 : 0, t = chunk * 128 + s;
    const bf16_t* base = UE + (size_t)chunk * 4 * 4096 + cc;
    const u32x4 zero4 = {0u, 0u, 0u, 0u};
    u32x4 pv, cv, nv;
    if (k == 0) {
      pv = has_prev(t) ? *(const u32x4*)(base - 4096) : zero4;
      cv = *(const u32x4*)base; nv = *(const u32x4*)(base + 4096);
    } else {
      pv = *(const u32x4*)(base + 2 * 4096); cv = *(const u32x4*)(base + 3 * 4096);
      nv = has_next(t) ? *(const u32x4*)(base + 4 * 4096) : zero4;
    }
    float xp[8], xc[8], xn[8], o[8];
    unpack8(pv, xp); unpack8(cv, xc); unpack8(nv, xn);
#pragma unroll
    for (int j = 0; j < 8; ++j) o[j] = silu(cb[cc + j] + cw[cc + j] * xp[j] + cw[4096 + cc + j] * xc[j] + cw[8192 + cc + j] * xn[j]);
    if (cc < 2048) {
#pragma unroll
      for (int j = 0; j < 8; ++j) XT[((size_t)chunk * 2048 + cc + j) * 128 + s] = f2bf(o[j]);
    } else {
      u32x4 v = {pk2(o[0], o[1]), pk2(o[2], o[3]), pk2(o[4], o[5]), pk2(o[6], o[7])};
      if (cc < 3072) *(u32x4*)(Bm + (size_t)t * 1024 + cc - 2048) = v;
      else *(u32x4*)(Cm + (size_t)t * 1024 + cc - 3072) = v;
    }
  }
}

DI void ssd_cumsum_phase(const float* __restrict__ DT, const float* __restrict__ a_log, float* __restrict__ ACST,
                         float* __restrict__ BST, float* __restrict__ WST, float* __restrict__ DEC) {
  for (int i = obid() * 256 + otid(); i < 128 * 64; i += VGRID * 256) {
    const int chunk = i >> 6, hd = i & 63;
    const float a = -__expf(a_log[hd]);
    const float* dp = DT + (size_t)(chunk * 128) * 64 + hd;
    float tot = 0.f;
#pragma unroll 1
    for (int b = 0; b < 8; ++b) {
      float d[16];
#pragma unroll
      for (int k = 0; k < 16; ++k) d[k] = dp[(size_t)(16 * b + k) * 64];
#pragma unroll
      for (int k = 0; k < 16; ++k) tot += d[k] * a;
    }
    const bool bwd = hd >= 32;
    float run = 0.f;
    float* pa = ACST + (size_t)i * 128; float* pb = BST + (size_t)i * 128; float* pw = WST + (size_t)i * 128;
#pragma unroll 1
    for (int b = 0; b < 8; ++b) {
      float d[16];
#pragma unroll
      for (int k = 0; k < 16; ++k) { const int s = bwd ? 127 - (16 * b + k) : 16 * b + k; d[k] = dp[(size_t)s * 64]; }
#pragma unroll
      for (int k = 0; k < 16; ++k) {
        const int s = bwd ? 127 - (16 * b + k) : 16 * b + k;
        run += d[k] * a;
        pa[s] = run;
        pb[s] = run - __logf(d[k]);
        pw[s] = __expf(tot - run) * d[k];
      }
    }
    DEC[i] = __expf(tot);
  }
}

DI void ssd_states_phase(const bf16_t* __restrict__ XT, const bf16_t* __restrict__ Bm, const float* __restrict__ WST,
                         bf16_t* __restrict__ S, char* smem) {
  bf16_t* sBT = (bf16_t*)smem;
  const int tid = otid(), lane = tid & 63, w = tid >> 6, l31 = lane & 31, half = lane >> 5;
  for (int it = obid(); it < 1024; it += VGRID) {
    const int chunk = it >> 3, g = it & 7, t0 = chunk * 128;
    __syncthreads();
#pragma unroll 2
    for (int idx = tid; idx < 128 * 16; idx += 256) {
      const int s = idx >> 4, n8 = (idx & 15) * 8;
      const u32x4 v = *(const u32x4*)(Bm + (size_t)(t0 + s) * 1024 + g * 128 + n8);
      bf16_t* dp = sBT + n8 * 136 + s;
      dp[0 * 136] = (bf16_t)(v.x & 0xffff); dp[1 * 136] = (bf16_t)(v.x >> 16);
      dp[2 * 136] = (bf16_t)(v.y & 0xffff); dp[3 * 136] = (bf16_t)(v.y >> 16);
      dp[4 * 136] = (bf16_t)(v.z & 0xffff); dp[5 * 136] = (bf16_t)(v.z >> 16);
      dp[6 * 136] = (bf16_t)(v.w & 0xffff); dp[7 * 136] = (bf16_t)(v.w >> 16);
    }
    __syncthreads();
    const int h = g * 4 + w;
    u32x4 xa[2][8];
    const bf16_t* xbase = XT + ((size_t)chunk * 2048 + h * 64 + l31) * 128 + 8 * half;
#pragma unroll
    for (int mt = 0; mt < 2; ++mt)
#pragma unroll
      for (int ks = 0; ks < 8; ++ks) xa[mt][ks] = *(const u32x4*)(xbase + mt * 32 * 128 + 16 * ks);
    const bf16_t* bbase = sBT + l31 * 136 + 8 * half;
#pragma unroll 1
    for (int dn = 0; dn < 4; ++dn) {
      const int d = dn >> 1, nh = dn & 1;
      const int hd = d * 32 + h;
      f32x16 acc[2][2];
#pragma unroll
      for (int i = 0; i < 2; ++i)
#pragma unroll
        for (int j = 0; j < 2; ++j) zero16(acc[i][j]);
      const float* wp = WST + ((size_t)chunk * 64 + hd) * 128 + 8 * half;
      const bf16_t* bb = bbase + (64 * nh) * 136;
#pragma unroll
      for (int ks = 0; ks < 8; ++ks) {
        const f32x4 w0 = *(const f32x4*)(wp + 16 * ks);
        const f32x4 w1 = *(const f32x4*)(wp + 16 * ks + 4);
        bf16x8 a[2];
#pragma unroll
        for (int mt = 0; mt < 2; ++mt) {
          const u32x4 xv = xa[mt][ks];
          a[mt] = pack8(lo_f(xv.x) * w0.x, hi_f(xv.x) * w0.y, lo_f(xv.y) * w0.z, hi_f(xv.y) * w0.w,
                        lo_f(xv.z) * w1.x, hi_f(xv.z) * w1.y, lo_f(xv.w) * w1.z, hi_f(xv.w) * w1.w);
        }
#pragma unroll
        for (int nt = 0; nt < 2; ++nt) {
          const bf16x8 b = ld8(bb + (32 * nt) * 136 + 16 * ks);
          acc[0][nt] = MFMA(a[0], b, acc[0][nt]);
          acc[1][nt] = MFMA(a[1], b, acc[1][nt]);
        }
      }
      bf16_t* sp = S + (((size_t)chunk * 2 + d) * 32 + h) * 8192 + (4 * half) * 128 + 64 * nh + l31;
#pragma unroll
      for (int mt = 0; mt < 2; ++mt)
#pragma unroll
        for (int nt = 0; nt < 2; ++nt)
#pragma unroll
          for (int i = 0; i < 16; ++i) sp[(32 * mt + (i & 3) + 8 * (i >> 2)) * 128 + 32 * nt] = f2bf(acc[mt][nt][i]);
    }
  }
}

template <int NC>
DI void scan_item(bf16_t* __restrict__ S, const float* __restrict__ DEC, float (&hc)[8], int cbase, int d, int h, int pp, int n8) {
  u32x4 v[NC];
  float dec[NC];
#pragma unroll
  for (int ci = 0; ci < NC; ++ci) {
    const int chunk = cbase + (d == 0 ? ci : NC - 1 - ci);
    v[ci] = *(const u32x4*)(S + ((((size_t)chunk * 2 + d) * 32 + h) * 64 + pp) * 128 + n8);
    dec[ci] = DEC[chunk * 64 + d * 32 + h];
  }
#pragma unroll
  for (int ci = 0; ci < NC; ++ci) {
    const int chunk = cbase + (d == 0 ? ci : NC - 1 - ci);
    float tmp[8];
    unpack8(v[ci], tmp);
    u32x4 o = {pk2(hc[0], hc[1]), pk2(hc[2], hc[3]), pk2(hc[4], hc[5]), pk2(hc[6], hc[7])};
    *(u32x4*)(S + ((((size_t)chunk * 2 + d) * 32 + h) * 64 + pp) * 128 + n8) = o;
#pragma unroll
    for (int q = 0; q < 8; ++q) hc[q] = hc[q] * dec[ci] + tmp[q];
  }
}
DI void ssd_scan_phase(bf16_t* __restrict__ S, const float* __restrict__ DEC, const float* __restrict__ state_ssm, int j, float* __restrict__ out_state) {
  for (int idx = obid() * 256 + otid(); idx < 36 * 65536; idx += VGRID * 256) {
    const int n8 = (idx & 15) * 8, pp = (idx >> 4) & 63, h = (idx >> 10) & 31, d = (idx >> 15) & 1, seq = idx >> 16;
    float hc[8];
    if (seq < 32) {
      float zz = 0.f;
      asm volatile("" : "+v"(zz));
#pragma unroll
      for (int q = 0; q < 8; ++q) hc[q] = zz;
      scan_item<2>(S, DEC, hc, seq * 2, d, h, pp, n8);
      float* op = out_state + ((((size_t)seq * 2 + j) * 2 + d) * 32 + h) * 8192 + pp * 128 + n8;
      f32x4 a = {hc[0], hc[1], hc[2], hc[3]}, b = {hc[4], hc[5], hc[6], hc[7]};
      __builtin_nontemporal_store(a, (f32x4*)op); __builtin_nontemporal_store(b, (f32x4*)(op + 4));
    } else {
      const float* sp = state_ssm + ((((size_t)(seq - 32) * 2 + j) * 2 + d) * 32 + h) * 8192 + pp * 128 + n8;
      const f32x4 a = *(const f32x4*)sp, b = *(const f32x4*)(sp + 4);
      hc[0] = a.x; hc[1] = a.y; hc[2] = a.z; hc[3] = a.w; hc[4] = b.x; hc[5] = b.y; hc[6] = b.z; hc[7] = b.w;
      scan_item<16>(S, DEC, hc, 64 + (seq - 32) * 16, d, h, pp, n8);
    }
  }
}

DI void ssd_y_phase(const bf16_t* __restrict__ XT, const bf16_t* __restrict__ Bm, const bf16_t* __restrict__ Cm, const bf16_t* __restrict__ S,
                    const float* __restrict__ ACST, const float* __restrict__ BST, const float* __restrict__ dskip, bf16_t* Z, char* smem) {
  constexpr int RS = 272;
  constexpr int TB = 64 * RS;
  const int tid = otid(), lane = tid & 63, w = tid >> 6, l31 = lane & 31, half = lane >> 5;
  for (int it = obid(); it < 1024; it += VGRID) {
    const int chunk = it >> 3, g = it & 7, t0 = chunk * 128;
    const int qc = 32 * w + l31;
    bf16x8 cmf[8];
    {
      const bf16_t* cp = Cm + (size_t)(t0 + qc) * 1024 + g * 128 + 8 * half;
#pragma unroll
      for (int ks = 0; ks < 8; ++ks) cmf[ks] = ld8(cp + 16 * ks);
    }
    f32x16 cbt[4];
#pragma unroll
    for (int mt = 0; mt < 4; ++mt) zero16(cbt[mt]);
    {
      const bf16_t* bp = Bm + (size_t)(t0 + l31) * 1024 + g * 128 + 8 * half;
#pragma unroll
      for (int ks = 0; ks < 8; ++ks) {
#pragma unroll
        for (int mt = 0; mt < 4; ++mt) {
          const bf16x8 a = ld8(bp + (size_t)(32 * mt) * 1024 + 16 * ks);
          cbt[mt] = MFMA(a, cmf[ks], cbt[mt]);
        }
      }
    }
#pragma unroll 1
    for (int r = 0; r < 4; ++r) {
      const int h = g * 4 + r;
      __syncthreads();
      {
        const bf16_t* src0 = XT + ((size_t)chunk * 2048 + h * 64) * 128;
        const bf16_t* src1 = S + (((size_t)chunk * 2 + 0) * 32 + h) * 8192;
        const bf16_t* src2 = S + (((size_t)chunk * 2 + 1) * 32 + h) * 8192;
        u32x4 v0[4], v1[4], v2[4];
#pragma unroll
        for (int i = 0; i < 4; ++i) {
          const int idx = tid + 256 * i;
          v0[i] = *(const u32x4*)(src0 + idx * 8);
          v1[i] = *(const u32x4*)(src1 + idx * 8);
          v2[i] = *(const u32x4*)(src2 + idx * 8);
        }
#pragma unroll
        for (int i = 0; i < 4; ++i) {
          const int idx = tid + 256 * i;
          char* dp = smem + (idx >> 4) * RS + (idx & 15) * 16;
          *(u32x4*)dp = v0[i];
          *(u32x4*)(dp + TB) = v1[i];
          *(u32x4*)(dp + 2 * TB) = v2[i];
        }
      }
      __syncthreads();
      f32x16 yd[2];
      zero16(yd[0]); zero16(yd[1]);
#pragma unroll 1
      for (int d = 0; d < 2; ++d) {
        const int hd = d * 32 + h;
        const float* acsp = ACST + ((size_t)chunk * 64 + hd) * 128;
        const float* bsp = BST + ((size_t)chunk * 64 + hd) * 128 + 4 * half;
        const float aq = acsp[qc];
        f32x16 yo[2];
        zero16(yo[0]); zero16(yo[1]);
        const char* sp = smem + (1 + d) * TB + l31 * RS + 16 * half;
#pragma unroll
        for (int ks = 0; ks < 8; ++ks) {
#pragma unroll
          for (int nt = 0; nt < 2; ++nt) {
            const bf16x8 bfr = *(const bf16x8*)(sp + (32 * nt) * RS + 32 * ks);
            yo[nt] = MFMA(cmf[ks], bfr, yo[nt]);
          }
        }
#pragma unroll
        for (int qd = 0; qd < 4; ++qd) {
          const f32x4 e4 = *(const f32x4*)(acsp + 32 * w + 8 * qd + 4 * half);
          const float e0 = __expf(e4.x), e1 = __expf(e4.y), e2 = __expf(e4.z), e3 = __expf(e4.w);
#pragma unroll
          for (int nt = 0; nt < 2; ++nt) {
            yd[nt][4 * qd + 0] += e0 * yo[nt][4 * qd + 0]; yd[nt][4 * qd + 1] += e1 * yo[nt][4 * qd + 1];
            yd[nt][4 * qd + 2] += e2 * yo[nt][4 * qd + 2]; yd[nt][4 * qd + 3] += e3 * yo[nt][4 * qd + 3];
          }
        }
        const char* xtp = smem + l31 * RS + 8 * half;
#pragma unroll
        for (int mt = 0; mt < 4; ++mt) {
          const bool need = (d == 0) ? (mt <= w) : (mt >= w);
          if (need) {
#pragma unroll
            for (int ss = 0; ss < 2; ++ss) {
              const int sb = 32 * mt + 16 * ss;
              const f32x4 b0 = *(const f32x4*)(bsp + sb);
              const f32x4 b1 = *(const f32x4*)(bsp + sb + 8);
              const float bsv[8] = {b0.x, b0.y, b0.z, b0.w, b1.x, b1.y, b1.z, b1.w};
              float lv[8];
#pragma unroll
              for (int jj = 0; jj < 8; ++jj) {
                const int s = sb + 4 * half + (jj & 3) + 8 * (jj >> 2);
                const bool ok = (d == 0) ? (s <= qc) : (s >= qc);
                const float arg = ok ? (aq - bsv[jj]) : -1e30f;
                lv[jj] = cbt[mt][8 * ss + jj] * __expf(arg);
              }
              const bf16x8 xa = pack8(lv[0], lv[1], lv[2], lv[3], lv[4], lv[5], lv[6], lv[7]);
#pragma unroll
              for (int nt = 0; nt < 2; ++nt) {
                const char* xp = xtp + (32 * nt) * RS + sb * 2;
                const u32x2 lo = *(const u32x2*)xp, hi = *(const u32x2*)(xp + 16);
                u32x4 xv = {lo.x, lo.y, hi.x, hi.y};
                yd[nt] = MFMA(xa, __builtin_bit_cast(bf16x8, xv), yd[nt]);
              }
            }
          }
        }
      }
      const float dsk = dskip[h];
#pragma unroll
      for (int nt = 0; nt < 2; ++nt) {
        const int c = h * 64 + 32 * nt + l31;
        const char* xq = smem + (32 * nt + l31) * RS + (32 * w + 4 * half) * 2;
        bf16_t* zp = Z + (size_t)(t0 + 32 * w + 4 * half) * 2048 + c;
#pragma unroll
        for (int qd = 0; qd < 4; ++qd) {
          const u32x2 xv = *(const u32x2*)(xq + 16 * qd);
          const float xs[4] = {lo_f(xv.x), hi_f(xv.x), lo_f(xv.y), hi_f(xv.y)};
#pragma unroll
          for (int e = 0; e < 4; ++e) {
            bf16_t* zz = zp + (size_t)(8 * qd + e) * 2048;
            const float zv = bf2f(*zz);
            const float y = yd[nt][4 * qd + e] + dsk * xs[e];
            *zz = f2bf(y * silu(zv));
          }
        }
      }
    }
  }
  __syncthreads();
}

DI void ssq_phase(const bf16_t* __restrict__ YZ, float* __restrict__ RSTD) {
  const int lane = otid() & 63;
  const int wid = obid() * 4 + (otid() >> 6), nw = VGRID * 4;
  for (int t = wid; t < T; t += nw) {
    float ssq = 0.f;
#pragma unroll
    for (int j = 0; j < 4; ++j) {
      float v[8];
      unpack8(*(const u32x4*)(YZ + (size_t)t * 2048 + lane * 8 + 512 * j), v);
#pragma unroll
      for (int q = 0; q < 8; ++q) ssq += v[q] * v[q];
    }
    ssq = wave_sum(ssq);
    if (lane == 0) RSTD[t] = rsqrtf(ssq * (1.f / 2048.f) + EPS);
  }
}

DI void sc_mid_phase(const bf16_t* __restrict__ BCU, const float* __restrict__ cw, bf16_t* __restrict__ H) {
  for (int i = obid() * 256 + otid(); i < (T / 4) * 128; i += VGRID * 256) {
    const int t0 = (i >> 7) * 4, c = (i & 127) * 8;
    const bool hp = has_prev(t0), hn = has_next(t0 + 3);
    const u32x4 zero4 = {0u, 0u, 0u, 0u};
    u32x4 ar[6], br[6], gr[4];
#pragma unroll
    for (int r = 0; r < 6; ++r) {
      const bool valid = (r == 0) ? hp : (r == 5) ? hn : true;
      const bf16_t* p = BCU + (size_t)(t0 - 1 + r) * 3072 + c;
      ar[r] = valid ? *(const u32x4*)(p + 1024) : zero4;
      br[r] = valid ? *(const u32x4*)(p + 2048) : zero4;
    }
#pragma unroll
    for (int k = 0; k < 4; ++k) gr[k] = *(const u32x4*)(BCU + (size_t)(t0 + k) * 3072 + c);
    float w0[8], w1[8], w2[8];
    {
      const f32x4 a0 = *(const f32x4*)(cw + c), a1 = *(const f32x4*)(cw + c + 4);
      const f32x4 b0 = *(const f32x4*)(cw + 1024 + c), b1 = *(const f32x4*)(cw + 1024 + c + 4);
      const f32x4 c0 = *(const f32x4*)(cw + 2048 + c), c1 = *(const f32x4*)(cw + 2048 + c + 4);
      w0[0] = a0.x; w0[1] = a0.y; w0[2] = a0.z; w0[3] = a0.w; w0[4] = a1.x; w0[5] = a1.y; w0[6] = a1.z; w0[7] = a1.w;
      w1[0] = b0.x; w1[1] = b0.y; w1[2] = b0.z; w1[3] = b0.w; w1[4] = b1.x; w1[5] = b1.y; w1[6] = b1.z; w1[7] = b1.w;
      w2[0] = c0.x; w2[1] = c0.y; w2[2] = c0.z; w2[3] = c0.w; w2[4] = c1.x; w2[5] = c1.y; w2[6] = c1.z; w2[7] = c1.w;
    }
#pragma unroll
    for (int k = 0; k < 4; ++k) {
      float a0[8], b0[8], a1[8], b1[8], a2[8], b2[8], bg[8], o[8];
      unpack8(ar[k], a0); unpack8(br[k], b0); unpack8(ar[k + 1], a1); unpack8(br[k + 1], b1); unpack8(ar[k + 2], a2); unpack8(br[k + 2], b2);
      unpack8(gr[k], bg);
#pragma unroll
      for (int j = 0; j < 8; ++j) o[j] = bg[j] * (w0[j] * (a0[j] * b0[j]) + w1[j] * (a1[j] * b1[j]) + w2[j] * (a2[j] * b2[j]));
      u32x4 v = {pk2(o[0], o[1]), pk2(o[2], o[3]), pk2(o[4], o[5]), pk2(o[6], o[7])};
      *(u32x4*)(H + (size_t)(t0 + k) * 1024 + c) = v;
    }
  }
}

DI void ffn_gate_phase(const bf16_t* __restrict__ U, const float* __restrict__ cw, bf16_t* __restrict__ G) {
  for (int i = obid() * 256 + otid(); i < (T / 4) * 352; i += VGRID * 256) {
    const int tb = i / 352, c = (i - tb * 352) * 8, t0 = tb * 4;
    const bool hp = has_prev(t0), hn = has_next(t0 + 3);
    u32x4 gr[6], vr[6];
    const u32x4 zero4 = {0u, 0u, 0u, 0u};
#pragma unroll
    for (int r = 0; r < 6; ++r) {
      const bool valid = (r == 0) ? hp : (r == 5) ? hn : true;
      const bf16_t* up = U + (size_t)(t0 - 1 + r) * 5632 + c;
      gr[r] = valid ? *(const u32x4*)up : zero4;
      vr[r] = valid ? *(const u32x4*)(up + 2816) : zero4;
    }
    float wg[3][8], wv[3][8];
#pragma unroll
    for (int k = 0; k < 3; ++k) {
      const f32x4 a0 = *(const f32x4*)(cw + k * 5632 + c), a1 = *(const f32x4*)(cw + k * 5632 + c + 4);
      const f32x4 b0 = *(const f32x4*)(cw + k * 5632 + 2816 + c), b1 = *(const f32x4*)(cw + k * 5632 + 2816 + c + 4);
      wg[k][0] = a0.x; wg[k][1] = a0.y; wg[k][2] = a0.z; wg[k][3] = a0.w; wg[k][4] = a1.x; wg[k][5] = a1.y; wg[k][6] = a1.z; wg[k][7] = a1.w;
      wv[k][0] = b0.x; wv[k][1] = b0.y; wv[k][2] = b0.z; wv[k][3] = b0.w; wv[k][4] = b1.x; wv[k][5] = b1.y; wv[k][6] = b1.z; wv[k][7] = b1.w;
    }
#pragma unroll
    for (int k = 0; k < 4; ++k) {
      float g0[8], g1[8], g2[8], v0[8], v1[8], v2[8], o[8];
      unpack8(gr[k], g0); unpack8(gr[k + 1], g1); unpack8(gr[k + 2], g2);
      unpack8(vr[k], v0); unpack8(vr[k + 1], v1); unpack8(vr[k + 2], v2);
#pragma unroll
      for (int j = 0; j < 8; ++j) {
        const float gg = wg[0][j] * g0[j] + wg[1][j] * g1[j] + wg[2][j] * g2[j];
        const float vv = wv[0][j] * v0[j] + wv[1][j] * v1[j] + wv[2][j] * v2[j];
        o[j] = silu(gg) * vv;
      }
      u32x4 ov = {pk2(o[0], o[1]), pk2(o[2], o[3]), pk2(o[4], o[5]), pk2(o[6], o[7])};
      *(u32x4*)(G + (size_t)(t0 + k) * 2816 + c) = ov;
    }
  }
}

DI void ffn_fix_phase(const bf16_t* __restrict__ UE, const float* __restrict__ cw, bf16_t* __restrict__ G) {
  for (int i = obid() * 256 + otid(); i < 128 * 2 * 352; i += VGRID * 256) {
    const int c = (i % 352) * 8, k = (i / 352) & 1, wt = i / 704;
    const int t = wt * 128 + (k ? 127 : 0);
    const int pc = (c >> 5) * 64 + (c & 31);
    const bf16_t* base = UE + (size_t)wt * 4 * 5632 + pc;
    const u32x4 zero4 = {0u, 0u, 0u, 0u};
    u32x4 gpv, gcv, gnv, vpv, vcv, vnv;
    if (k == 0) {
      const bool hp = has_prev(t);
      gpv = hp ? *(const u32x4*)(base - 5632) : zero4;
      vpv = hp ? *(const u32x4*)(base - 5632 + 32) : zero4;
      gcv = *(const u32x4*)base; vcv = *(const u32x4*)(base + 32);
      gnv = *(const u32x4*)(base + 5632); vnv = *(const u32x4*)(base + 5632 + 32);
    } else {
      const bool hn = has_next(t);
      gpv = *(const u32x4*)(base + 2 * 5632); vpv = *(const u32x4*)(base + 2 * 5632 + 32);
      gcv = *(const u32x4*)(base + 3 * 5632); vcv = *(const u32x4*)(base + 3 * 5632 + 32);
      gnv = hn ? *(const u32x4*)(base + 4 * 5632) : zero4;
      vnv = hn ? *(const u32x4*)(base + 4 * 5632 + 32) : zero4;
    }
    float gp[8], gc[8], gn[8], vp[8], vc[8], vn[8], o[8];
    unpack8(gpv, gp); unpack8(gcv, gc); unpack8(gnv, gn); unpack8(vpv, vp); unpack8(vcv, vc); unpack8(vnv, vn);
#pragma unroll
    for (int j = 0; j < 8; ++j) {
      const float gg = cw[c + j] * gp[j] + cw[5632 + c + j] * gc[j] + cw[11264 + c + j] * gn[j];
      const float vv = cw[2816 + c + j] * vp[j] + cw[5632 + 2816 + c + j] * vc[j] + cw[11264 + 2816 + c + j] * vn[j];
      o[j] = silu(gg) * vv;
    }
    u32x4 ov = {pk2(o[0], o[1]), pk2(o[2], o[3]), pk2(o[4], o[5]), pk2(o[6], o[7])};
    *(u32x4*)(G + (size_t)t * 2816 + c) = ov;
  }
}

DI void cache_phase(const float* __restrict__ ck, const float* __restrict__ cv, bf16_t* __restrict__ KB, bf16_t* __restrict__ VT) {
  for (int i = obid() * 256 + otid(); i < 4 * 256 * 1024; i += VGRID * 256) {
    const int c = i & 1023, jk = (i >> 10) & 255, b = i >> 18;
    KB[(size_t)(TP + b * 2304 + jk) * 1024 + c] = f2bf(ck[i]);
    VT[(size_t)TP * 1024 + (size_t)b * 1024 * 2304 + (size_t)c * 2304 + jk] = f2bf(cv[i]);
  }
}

DI void attn_phase(const bf16_t* __restrict__ Q, const bf16_t* __restrict__ KB, const bf16_t* __restrict__ VT, bf16_t* __restrict__ O,
                   const float* __restrict__ gsub, float lam, float lam_init, char* smem) {
  constexpr int KRS = 272, VRS = 72;
  constexpr int KB_BYTES = 32 * KRS;
  constexpr int BUF = KB_BYTES + 128 * VRS;
  const int tid = otid(), lane = tid & 63, w = tid >> 6, l31 = lane & 31, half = lane >> 5;
  const int krow0 = tid >> 4, kc = tid & 15;
  const int vrow0 = tid >> 2, vc = tid & 3;
  for (int it = obid(); it < 1024; it += VGRID) {
    int seqt0, kb0, L, hp, qb; size_t vbase;
    if (it < 512) { const int b = it >> 7; hp = (it >> 4) & 7; qb = it & 15; seqt0 = TP + b * 2048; kb0 = TP + b * 2304; L = 2304; vbase = (size_t)TP * 1024 + (size_t)b * 1024 * 2304; }
    else { const int i2 = it - 512; const int s = i2 >> 4; hp = (i2 >> 1) & 7; qb = i2 & 1; seqt0 = s * 256; kb0 = s * 256; L = 256; vbase = (size_t)s * 1024 * 256; }
    const int tq = seqt0 + qb * 128 + w * 32 + l31;
    const int ntile = L >> 5;
    bf16x8 qf0[4], qf1[4];
    {
      const bf16_t* qp = Q + (size_t)tq * 1024 + (2 * hp) * 64 + 8 * half;
#pragma unroll
      for (int ks = 0; ks < 4; ++ks) { qf0[ks] = ld8(qp + 16 * ks); qf1[ks] = ld8(qp + 64 + 16 * ks); }
    }
    const bf16_t* kg = KB + (size_t)(kb0 + krow0) * 1024 + (2 * hp) * 64 + kc * 8;
    const bf16_t* vg = VT + vbase + (size_t)(hp * 128 + vrow0) * L + vc * 8;
    char* kdst = smem + krow0 * KRS + kc * 16;
    char* vdst = smem + KB_BYTES + vrow0 * VRS + vc * 16;
    const char* kfr = smem + l31 * KRS + 16 * half;
    const char* vfr = smem + KB_BYTES + l31 * VRS + 8 * half;

    float m0 = -1e30f, m1 = -1e30f, l0 = 0.f, l1 = 0.f;
#define ATT_QK(s0_, s1_, cur_)                                                              \
    do {                                                                                    \
      zero16(s0_); zero16(s1_);                                                             \
      _Pragma("unroll") for (int ks = 0; ks < 4; ++ks) {                                    \
        const bf16x8 a0 = *(const bf16x8*)(kfr + (cur_) + 32 * ks);                         \
        s0_ = MFMA(a0, qf0[ks], s0_);                                                            \
      }                                                                                     \
      __builtin_amdgcn_sched_barrier(0);                                                    \
      _Pragma("unroll") for (int ks = 0; ks < 4; ++ks) {                                    \
        const bf16x8 a1 = *(const bf16x8*)(kfr + (cur_) + 128 + 32 * ks);                   \
        s1_ = MFMA(a1, qf1[ks], s1_);                                                            \
      }                                                                                     \
      __builtin_amdgcn_sched_barrier(0);                                                    \
    } while (0)
    __syncthreads();
    {
      const u32x4 k0 = *(const u32x4*)kg, k1 = *(const u32x4*)(kg + 16 * 1024);
      *(u32x4*)kdst = k0; *(u32x4*)(kdst + 16 * KRS) = k1;
    }
    __syncthreads();
#pragma unroll 1
    for (int ti = 0; ti < ntile; ++ti) {
      const int cur = (ti & 1) * BUF, nxt = BUF - cur;
      const bool more = ti + 1 < ntile;
      u32x4 k0, k1;
      if (more) {
        const bf16_t* kq = kg + (size_t)(ti + 1) * 32 * 1024;
        k0 = *(const u32x4*)kq; k1 = *(const u32x4*)(kq + 16 * 1024);
      }
      f32x16 s0, s1;
      ATT_QK(s0, s1, cur);
      float x0 = s0[0], x1 = s1[0];
#pragma unroll
      for (int i = 1; i < 16; ++i) { x0 = fmaxf(x0, s0[i]); x1 = fmaxf(x1, s1[i]); }
      const float n0 = fmaxf(m0, x0), n1 = fmaxf(m1, x1);
      float p0 = 0.f, p1 = 0.f;
#pragma unroll
      for (int i = 0; i < 16; ++i) { p0 += __builtin_amdgcn_exp2f(s0[i] - n0); p1 += __builtin_amdgcn_exp2f(s1[i] - n1); }
      l0 = l0 * __builtin_amdgcn_exp2f(m0 - n0) + p0; m0 = n0;
      l1 = l1 * __builtin_amdgcn_exp2f(m1 - n1) + p1; m1 = n1;
      if (more) { *(u32x4*)(kdst + nxt) = k0; *(u32x4*)(kdst + nxt + 16 * KRS) = k1; }
      __syncthreads();
    }
    {
      const float mo0 = shx(m0, 32), lo0 = shx(l0, 32);
      const float mo1 = shx(m1, 32), lo1 = shx(l1, 32);
      const float M0 = fmaxf(m0, mo0), M1 = fmaxf(m1, mo1);
      l0 = l0 * __builtin_amdgcn_exp2f(m0 - M0) + lo0 * __builtin_amdgcn_exp2f(mo0 - M0); m0 = M0;
      l1 = l1 * __builtin_amdgcn_exp2f(m1 - M1) + lo1 * __builtin_amdgcn_exp2f(mo1 - M1); m1 = M1;
    }
    const float c0 = 1.f / l0, c1 = -lam / l1;
    f32x16 o[4];
#pragma unroll
    for (int et = 0; et < 4; ++et) zero16(o[et]);
    {
      const u32x4 k0 = *(const u32x4*)kg, k1 = *(const u32x4*)(kg + 16 * 1024);
      const u32x4 v0 = *(const u32x4*)vg, v1 = *(const u32x4*)(vg + (size_t)64 * L);
      *(u32x4*)kdst = k0; *(u32x4*)(kdst + 16 * KRS) = k1;
      u32x2 a = {v0.x, v0.y}, b = {v0.z, v0.w}, c = {v1.x, v1.y}, d = {v1.z, v1.w};
      *(u32x2*)vdst = a; *(u32x2*)(vdst + 8) = b; *(u32x2*)(vdst + 64 * VRS) = c; *(u32x2*)(vdst + 64 * VRS + 8) = d;
    }
    __syncthreads();
#pragma unroll 1
    for (int ti = 0; ti < ntile; ++ti) {
      const int cur = (ti & 1) * BUF, nxt = BUF - cur;
      const bool more = ti + 1 < ntile;
      u32x4 k0, k1, v0, v1;
      if (more) {
        const bf16_t* kq = kg + (size_t)(ti + 1) * 32 * 1024;
        k0 = *(const u32x4*)kq; k1 = *(const u32x4*)(kq + 16 * 1024);
        const bf16_t* vq = vg + (ti + 1) * 32;
        v0 = *(const u32x4*)vq; v1 = *(const u32x4*)(vq + (size_t)64 * L);
      }
      f32x16 s0, s1;
      ATT_QK(s0, s1, cur);
#pragma unroll
      for (int i = 0; i < 16; ++i) s0[i] = c0 * __builtin_amdgcn_exp2f(s0[i] - m0) + c1 * __builtin_amdgcn_exp2f(s1[i] - m1);
#pragma unroll
      for (int ss = 0; ss < 2; ++ss) {
        const bf16x8 pb = pack8(s0[8 * ss + 0], s0[8 * ss + 1], s0[8 * ss + 2], s0[8 * ss + 3],
                                s0[8 * ss + 4], s0[8 * ss + 5], s0[8 * ss + 6], s0[8 * ss + 7]);
#pragma unroll
        for (int et = 0; et < 4; ++et) {
          const char* vq = vfr + cur + (32 * et) * VRS + 32 * ss;
          const u32x2 lo = *(const u32x2*)vq, hi = *(const u32x2*)(vq + 16);
          u32x4 vv = {lo.x, lo.y, hi.x, hi.y};
          o[et] = MFMA(__builtin_bit_cast(bf16x8, vv), pb, o[et]);
        }
      }
      if (more) {
        *(u32x4*)(kdst + nxt) = k0; *(u32x4*)(kdst + nxt + 16 * KRS) = k1;
        u32x2 a = {v0.x, v0.y}, b = {v0.z, v0.w}, c = {v1.x, v1.y}, d = {v1.z, v1.w};
        *(u32x2*)(vdst + nxt) = a; *(u32x2*)(vdst + nxt + 8) = b;
        *(u32x2*)(vdst + nxt + 64 * VRS) = c; *(u32x2*)(vdst + nxt + 64 * VRS + 8) = d;
      }
      __syncthreads();
    }
#undef ATT_QK
    float ssq = 0.f;
#pragma unroll
    for (int et = 0; et < 4; ++et)
#pragma unroll
      for (int i = 0; i < 16; ++i) ssq += o[et][i] * o[et][i];
    ssq += shx(ssq, 32);
    const float r = rsqrtf(ssq * (1.f / 128.f) + EPS) * (1.f - lam_init);
    bf16_t* op = O + (size_t)tq * 1024 + hp * 128 + 4 * half;
#pragma unroll
    for (int et = 0; et < 4; ++et)
#pragma unroll
      for (int qd = 0; qd < 4; ++qd) {
        const int e = 32 * et + 8 * qd;
        const f32x4 g4 = *(const f32x4*)(gsub + e + 4 * half);
        u32x2 ov = {pk2(o[et][4 * qd + 0] * r * g4.x, o[et][4 * qd + 1] * r * g4.y),
                    pk2(o[et][4 * qd + 2] * r * g4.z, o[et][4 * qd + 3] * r * g4.w)};
        *(u32x2*)(op + e) = ov;
      }
  }
  __syncthreads();
}

typedef __attribute__((address_space(4))) const Params* KParams;
DI KParams PP() {
  KParams k = (KParams)__builtin_amdgcn_kernarg_segment_ptr();
  asm volatile("" : "+s"(k));
  return k;
}
#define XB_TMO      128
#define XB_XCNT(j)  (256  + 64 * (j))
#define XB_XSUB(j)  (1280 + 64 * (j))
#define XB_XGEN(j)  (2304 + 64 * (j))
#define XB_TOP      3328
#define XB_TOPGEN   3392
#define XCD_BAR_WORDS 3456
#define XB_SPIN_CAP (1u << 18)
#define LAS __attribute__((address_space(3)))

__device__ __forceinline__ unsigned xb_ld(unsigned* p)              { return __hip_atomic_load(p, __ATOMIC_RELAXED, __HIP_MEMORY_SCOPE_AGENT); }
__device__ __forceinline__ unsigned xb_add(unsigned* p, unsigned v) { return __hip_atomic_fetch_add(p, v, __ATOMIC_RELAXED, __HIP_MEMORY_SCOPE_AGENT); }
__device__ __forceinline__ unsigned xb_xcc_id() { return (unsigned)__builtin_amdgcn_s_getreg((3 << 11) | 20) & 0xFu; }
#define XB_SPIN(cond, bar) do { unsigned _sp = 0; while (cond) { __builtin_amdgcn_s_sleep(1); \
    if ((++_sp & 255u) == 0u) { if (xb_ld(&(bar)[XB_TMO])) break; if (_sp > XB_SPIN_CAP) { atomicAdd(&(bar)[XB_TMO], 1u); break; } } } } while (0)

struct XcdBarrier {
    unsigned* bar; unsigned x;
    volatile LAS unsigned* st;
};

__device__ __forceinline__ XcdBarrier xcd_barrier_post(unsigned* bar, volatile LAS unsigned* st) {
    XcdBarrier b; b.bar = bar; b.x = xb_xcc_id(); b.st = st;
    if (threadIdx.x == 0) (void)xb_add(&bar[XB_XCNT(b.x)], 1u);
    return b;
}
__device__ __forceinline__ void xcd_barrier_complete(unsigned* bar, unsigned x, unsigned& nloc, unsigned& nx) {
    const unsigned G = gridDim.x * gridDim.y * gridDim.z;
    unsigned sum, cnt, mine, sp = 0u;
    for (;;) {
        sum = 0u; cnt = 0u; mine = 0u;
#pragma unroll
        for (unsigned j = 0; j < 16; ++j) { const unsigned c = xb_ld(&bar[XB_XCNT(j)]); sum += c; cnt += (c > 0u) ? 1u : 0u; mine = (j == x) ? c : mine; }
        if (sum == G) break;
        __builtin_amdgcn_s_sleep(1);
        if ((++sp & 255u) == 0u) { if (xb_ld(&bar[XB_TMO])) break; if (sp > XB_SPIN_CAP) { atomicAdd(&bar[XB_TMO], 1u); break; } }
    }
    nloc = mine > 0u ? mine : 1u; nx = cnt > 0u ? cnt : 1u;
}

__device__ __forceinline__ void xcd_barrier(const XcdBarrier& b) {
    asm volatile("s_waitcnt vmcnt(0)" ::: "memory");
    __syncthreads();
    if (threadIdx.x == 0) {
        unsigned* bar = b.bar;
        __builtin_amdgcn_s_waitcnt(0);
        unsigned nloc = b.st[0], nx = b.st[1];
        if (nloc == 0u) { xcd_barrier_complete(bar, b.x, nloc, nx); b.st[0] = nloc; b.st[1] = nx; }
        const unsigned old = xb_add(&bar[XB_XSUB(b.x)], 1u);
        const unsigned gen = old / nloc;
        if (old + 1u == (gen + 1u) * nloc) {
            __builtin_amdgcn_fence(__ATOMIC_RELEASE, "agent");
            asm volatile("s_waitcnt vmcnt(0)" ::: "memory");
            const unsigned og = xb_add(&bar[XB_TOP], 1u);
            const unsigned tg = og / nx;
            if (og + 1u == (tg + 1u) * nx) xb_add(&bar[XB_TOPGEN], 1u);
            else XB_SPIN(xb_ld(&bar[XB_TOPGEN]) == tg, bar);
            __builtin_amdgcn_fence(__ATOMIC_ACQUIRE, "agent");
            xb_add(&bar[XB_XGEN(b.x)], 1u);
            asm volatile("s_waitcnt vmcnt(0)" ::: "memory");
        } else {
            XB_SPIN(xb_ld(&bar[XB_XGEN(b.x)]) == gen, bar);
            __builtin_amdgcn_fence(__ATOMIC_ACQUIRE, "agent");
            asm volatile("s_waitcnt vmcnt(0)" ::: "memory");
        }
    }
    __syncthreads();
}

#define WSB() (PP()->ws)
#define MOD ((float*)(WSB() + OFF_MOD))
#define ROTC ((float*)(WSB() + OFF_ROT))
#define ROTS ((float*)(WSB() + OFF_ROT) + 2048 * 32)
#define RSTD ((float*)(WSB() + OFF_RSTD))
#define DT ((float*)(WSB() + OFF_DT))
#define ACST ((float*)(WSB() + OFF_ACST))
#define BST ((float*)(WSB() + OFF_BST))
#define WST ((float*)(WSB() + OFF_WST))
#define DEC ((float*)(WSB() + OFF_DEC))
#define WA ((bf16_t*)(WSB() + OFF_WA))
#define WB ((bf16_t*)(WSB() + OFF_WB))
#define WU ((bf16_t*)(WSB() + OFF_WU))
#define WD ((bf16_t*)(WSB() + OFF_WD))
#define H ((bf16_t*)(WSB() + OFF_H))
#define RA (WSB() + OFF_RA)
#define RB (WSB() + OFF_RB)
#define xo (PP()->out)
#define GSYNC() do { XcdBarrier b_; b_.bar = (unsigned*)(WSB() + OFF_BAR); b_.x = xb_xcc_id(); b_.st = (volatile LAS unsigned*)&xb_words; xcd_barrier(b_); } while (0)
#define CONVERT_MIXER(L_, F_, S_)                                                                                             \
  do {                                                                                                                        \
    const int k_ = (L_) % 3, j_ = (L_) / 3;                                                                                   \
    if (k_ == 0) {                                                                                                            \
      convert_wt(PP()->ssd_w_in + (size_t)j_ * 1024 * 6208, 1024, 6208, WA, nullptr, vsm, false, F_, S_);                     \
      convert_wt(PP()->ssd_w_out + (size_t)j_ * 2048 * 1024, 2048, 1024, WB, PP()->ssd_norm_g + j_ * 2048, vsm, false, F_, S_); \
    } else if (k_ == 1) {                                                                                                     \
      convert_wt(PP()->sc_w_in, 1024, 3072, WA, nullptr, vsm, false, F_, S_);                                                 \
      convert_wt(PP()->sc_w_out, 1024, 1024, WB, nullptr, vsm, false, F_, S_);                                                \
    } else {                                                                                                                  \
      convert_wt(PP()->da_w_qkv, 1024, 3072, WA, nullptr, vsm, false, F_, S_);                                                \
      convert_wt(PP()->da_w_out, 1024, 1024, WB, nullptr, vsm, false, F_, S_);                                                \
    }                                                                                                                         \
  } while (0)
#define CONVERT_FFN(L_, F_, S_)                                                                                               \
  do {                                                                                                                        \
    convert_wt(PP()->ffn_w_up + (size_t)(L_) * 1024 * 5632, 1024, 5632, WU, nullptr, vsm, true, F_, S_);                      \
    convert_wt(PP()->ffn_w_down + (size_t)(L_) * 2816 * 1024, 2816, 1024, WD, nullptr, vsm, false, F_, S_);                   \
  } while (0)
#define TAIL_IDLE(NTN_) ((((NTN_) * 8) & 31) != 0 && ((obid() >> 4) >= (((NTN_) * 8) & 31)))
#define TAIL_FIRST(NTN_) ((((obid() >> 4) - (((NTN_) * 8) & 31)) * 8 + ((obid() >> 1) & 7)) * 2 + (obid() & 1))
#define TAIL_STRIDE(NTN_) ((32 - (((NTN_) * 8) & 31)) * 16)
__global__ void __launch_bounds__(512) mega(Params p) {
  __shared__ __attribute__((aligned(16))) char smem[131072];
  char* vsm = smem + (threadIdx.x >> 8) * 65536;
  cg::grid_group grid = cg::this_grid();

  __shared__ u32x4 xb_words;
  if (threadIdx.x == 0) { u32x4 z = {0u, 0u, 0u, 0u}; xb_words = z; }
  if (blockIdx.x == 0) for (int i = threadIdx.x; i < XCD_BAR_WORDS; i += 512) ((unsigned*)(WSB() + OFF_BAR))[i] = 0u;
  __syncthreads();
  mod_phase(PP()->c_ctx, PP()->c, PP()->w_mod, PP()->b_mod, MOD, vsm);
  rot_phase(ROTC, ROTS);
  CONVERT_MIXER(0, -1, 0);
  grid.sync();
  (void)xcd_barrier_post((unsigned*)(WSB() + OFF_BAR), (volatile LAS unsigned*)&xb_words);

  for (int l = 0; l < 4; ++l) {
    const int kind = l % 3, j = l / 3;
    const float* modl = MOD + (size_t)l * 5 * 6144;
    if (kind != 0) CONVERT_FFN(l, -1, 0);
    if (l == 0)
      row_phase(PP()->x_prompt, PP()->x_sample, nullptr, nullptr, nullptr, xo, H, PP()->norm_g + (l * 4 + 0) * 1024, modl + 0, modl + 1024);
    else
      row_phase(xo, xo + (size_t)TP * D, (const bf16_t*)RA, MOD + (size_t)(l - 1) * 5 * 6144 + 5120, PP()->norm_g + ((l - 1) * 4 + 3) * 1024,
                xo, H, PP()->norm_g + (l * 4 + 0) * 1024, modl + 0, modl + 1024);
    GSYNC();

    bf16_t* Mx = (bf16_t*)RB;
    if (kind == 0) {
      bf16_t* Z = (bf16_t*)RA;
      bf16_t* XBC = (bf16_t*)(RA + (size_t)T * 2048 * 2);
      bf16_t* S = XBC;
      bf16_t* XT = (bf16_t*)RB;
      bf16_t* Bm = (bf16_t*)(RB + (size_t)T * 2048 * 2);
      bf16_t* Cm = (bf16_t*)(RB + (size_t)T * 2048 * 2 + (size_t)T * 1024 * 2);
      {
        EpiSsdIn2 epi{Z, XT, Bm, Cm, (bf16_t*)(WSB() + OFF_UE), DT, PP()->ssd_dt_bias + j * 64,
                      PP()->ssd_conv_w + (size_t)j * 3 * 4096, PP()->ssd_conv_b + (size_t)j * 4096};
        gemm_phase(H, 1024, WA, 1024, 25, epi, smem);
      }
      if (gridDim.x == 256) { if (TAIL_IDLE(25)) CONVERT_FFN(l, TAIL_FIRST(25), TAIL_STRIDE(25)); }
      else CONVERT_FFN(l, -1, 0);
      GSYNC();
      ssd_fix_phase((const bf16_t*)(WSB() + OFF_UE), PP()->ssd_conv_w + (size_t)j * 3 * 4096, PP()->ssd_conv_b + (size_t)j * 4096, XT, Bm, Cm);
      ssd_cumsum_phase(DT, PP()->ssd_a_log + j * 64, ACST, BST, WST, DEC);
      GSYNC();
      ssd_states_phase(XT, Bm, WST, S, vsm);
      GSYNC();
      ssd_scan_phase(S, DEC, PP()->state_ssm, j, xo + OUT_STATE);
      GSYNC();
      ssd_y_phase(XT, Bm, Cm, S, ACST, BST, PP()->ssd_d + j * 32, Z, vsm);
      GSYNC();
      ssq_phase(Z, RSTD);
      GSYNC();
      {
        EpiBF16 epi{Mx, 1024, RSTD};
        gemm_phase(Z, 2048, WB, 2048, 4, epi, smem);
      }
      GSYNC();
    } else if (kind == 1) {
      bf16_t* BCU = (bf16_t*)RA;
      {
        EpiBF16 epi{BCU, 3072, nullptr};
        gemm_phase(H, 1024, WA, 1024, 12, epi, smem);
      }
      GSYNC();
      sc_mid_phase(BCU, PP()->sc_conv_w, H);
      GSYNC();
      {
        EpiBF16 epi{Mx, 1024, nullptr};
        gemm_phase(H, 1024, WB, 1024, 4, epi, smem);
      }
      GSYNC();
    } else {
      bf16_t* Q = (bf16_t*)RA;
      bf16_t* KB = (bf16_t*)(RA + (size_t)T * 1024 * 2);
      bf16_t* VT = (bf16_t*)(RA + (size_t)T * 1024 * 2 + (size_t)17408 * 1024 * 2);
      const float lam_init = 0.8f - 0.6f * __expf(-0.3f * (float)l);
      float d01 = 0.f, d23 = 0.f;
      for (int i = 0; i < 64; ++i) { d01 += PP()->da_lambda[i] * PP()->da_lambda[64 + i]; d23 += PP()->da_lambda[128 + i] * PP()->da_lambda[192 + i]; }
      const float lam = __expf(d01) - __expf(d23) + lam_init;
      cache_phase(PP()->cache_k, PP()->cache_v, KB, VT);
      {
        EpiQKV epi{Q, KB, VT, xo + OUT_CK, xo + OUT_CV, ROTC, ROTS};
        gemm_phase(H, 1024, WA, 1024, 12, epi, smem);
      }
      GSYNC();
      attn_phase(Q, KB, VT, H, PP()->da_subln_g, lam, lam_init, vsm);
      GSYNC();
      {
        EpiBF16 epi{Mx, 1024, nullptr};
        gemm_phase(H, 1024, WB, 1024, 4, epi, smem);
      }
      GSYNC();
    }
    row_phase(xo, xo + (size_t)TP * D, Mx, modl + 2048, PP()->norm_g + (l * 4 + 1) * 1024, xo, H, PP()->norm_g + (l * 4 + 2) * 1024, modl + 3072, modl + 4096);
    GSYNC();
    {
      EpiGate epi{(bf16_t*)RB, (bf16_t*)(WSB() + OFF_UE), PP()->ffn_conv_w + (size_t)l * 3 * 5632};
      gemm_phase(H, 1024, WU, 1024, 22, epi, smem);
    }
    if (l < 3) {
      if (gridDim.x == 256) { if (TAIL_IDLE(22)) CONVERT_MIXER(l + 1, TAIL_FIRST(22), TAIL_STRIDE(22)); }
      else CONVERT_MIXER(l + 1, -1, 0);
    }
    GSYNC();
    ffn_fix_phase((const bf16_t*)(WSB() + OFF_UE), PP()->ffn_conv_w + (size_t)l * 3 * 5632, (bf16_t*)RB);
    GSYNC();
    {
      EpiBF16 epi{(bf16_t*)RA, 1024, nullptr};
      gemm_phase((const bf16_t*)RB, 2816, WD, 2816, 4, epi, smem);
    }
    GSYNC();
  }
  row_phase(xo, xo + (size_t)TP * D, (const bf16_t*)RA, MOD + (size_t)3 * 5 * 6144 + 5120, PP()->norm_g + (3 * 4 + 3) * 1024,
            xo, nullptr, nullptr, nullptr, nullptr);
}

#undef MOD
#undef ROTC
#undef ROTS
#undef RSTD
#undef DT
#undef ACST
#undef BST
#undef WST
#undef DEC
#undef WA
#undef WB
#undef WU
#undef WD
#undef H
#undef RA
#undef RB
#undef xo
extern "C" void kernel_launch(void* const* d_in, const int* in_sizes, int n_in, void* d_out, int out_size, void* d_ws, size_t ws_size,
                              hipStream_t stream) {
  if (ws_size < WS_NEED) { fprintf(stderr, "workspace too small: %zu < %zu\n", ws_size, (size_t)WS_NEED); return; }
  static int grid_blocks = 0;
  if (!grid_blocks) {
    int dev = 0, cus = 0, per_cu = 0;
    hipGetDevice(&dev);
    hipDeviceGetAttribute(&cus, hipDeviceAttributeMultiprocessorCount, dev);
    hipOccupancyMaxActiveBlocksPerMultiprocessor(&per_cu, mega, 512, 0);
    if (per_cu > 1) per_cu = 1;
    grid_blocks = cus * per_cu;
  }
  Params p{};
  const float** pp = (const float**)&p;
  for (int i = 0; i < 28; ++i) pp[i] = (const float*)d_in[i];
  p.out = (float*)d_out;
  p.ws = (char*)d_ws;
  void* args[] = {&p};
  hipError_t e = hipLaunchCooperativeKernel((void*)mega, dim3(grid_blocks), dim3(512), args, 0, stream);
  if (e != hipSuccess) fprintf(stderr, "cooperative launch failed: %s (grid %d)\n", hipGetErrorString(e), grid_blocks);
}
```
